# Optimizing an MI355X kernel written in HIP

```python
import math
import jax, jax.numpy as jnp
from jax import lax
import numpy as np

D_MODEL = 1024
BATCH = 16
SEQ = 4096
DEPTH = 1

HEAD_DIM = 64
MIX_WIDTH = D_MODEL
A_HEADS = (MIX_WIDTH // 2) // HEAD_DIM
A_KV_HEADS = 2
A_GROUP = A_HEADS // A_KV_HEADS
B_HEADS = (MIX_WIDTH // 2) // HEAD_DIM
WINDOW = 128
BLOCK = 128
D_FF = 4 * D_MODEL
EPS = 1e-6

A_Q_W = A_HEADS * HEAD_DIM
A_KV_W = A_KV_HEADS * HEAD_DIM
B_W = B_HEADS * HEAD_DIM
IN_SPLITS = tuple(np.cumsum([A_Q_W, A_KV_W, A_KV_W, B_W, B_W, B_W]).tolist())
IN_WIDTH = A_Q_W + 2 * A_KV_W + 3 * B_W + B_HEADS

kernel_name = "hybrid_swa_sinks_fox_sqrelu"


def rmsnorm(x, g):
    x32 = x.astype(jnp.float32)
    y = x32 * lax.rsqrt(jnp.mean(x32 * x32, axis=-1, keepdims=True) + EPS)
    return (y * g.astype(jnp.float32)).astype(x.dtype)


def alibi_slopes(n):
    return jnp.exp2(-(8.0 / n) * (jnp.arange(n, dtype=jnp.float32) + 1.0))


def swa_sinks_attention(q, k, v, sinks):
    b, s, _, d = q.shape
    nb = s // BLOCK
    scale = 1.0 / math.sqrt(d)
    qb = q.reshape(b, nb, BLOCK, A_KV_HEADS, A_GROUP, d)
    pad = ((0, 0), (BLOCK, 0), (0, 0), (0, 0))
    kp = jnp.pad(k, pad).reshape(b, nb + 1, BLOCK, A_KV_HEADS, d)
    vp = jnp.pad(v, pad).reshape(b, nb + 1, BLOCK, A_KV_HEADS, d)
    kb = jnp.concatenate([kp[:, :-1], kp[:, 1:]], axis=2)
    vb = jnp.concatenate([vp[:, :-1], vp[:, 1:]], axis=2)
    scores = jnp.einsum('bnqkgd,bnskd->bnkgqs', qb, kb).astype(jnp.float32) * scale
    qpos = BLOCK + jnp.arange(BLOCK)
    kpos = jnp.arange(2 * BLOCK)
    dist = qpos[:, None] - kpos[None, :]
    band = (dist >= 0) & (dist < WINDOW)
    first_pad = (jnp.arange(nb) == 0)[:, None, None] & (kpos < BLOCK)[None, None, :]
    valid = band[None] & ~first_pad
    slopes = alibi_slopes(A_HEADS).reshape(A_KV_HEADS, A_GROUP)
    alibi = -slopes[:, :, None, None] * dist.astype(jnp.float32)[None, None]
    scores = scores + alibi[None, None]
    scores = jnp.where(valid[None, :, None, None], scores, -jnp.inf)
    sink = sinks.astype(jnp.float32).reshape(1, 1, A_KV_HEADS, A_GROUP, 1, 1)
    m = jnp.maximum(jnp.max(scores, axis=-1, keepdims=True), sink)
    p = jnp.exp(scores - m)
    denom = jnp.sum(p, axis=-1, keepdims=True) + jnp.exp(sink - m)
    p = (p / denom).astype(v.dtype)
    out = jnp.einsum('bnkgqs,bnskd->bnqkgd', p, vb)
    return out.reshape(b, s, A_HEADS, d)


def forgetting_attention(q, k, v, log_f):
    b, s, h, d = q.shape
    nb = s // BLOCK
    scale = 1.0 / math.sqrt(d)
    c = jnp.cumsum(log_f, axis=1)
    c_keys = jnp.transpose(c, (0, 2, 1))
    qb = jnp.moveaxis(q.reshape(b, nb, BLOCK, h, d), 1, 0)
    cb = jnp.moveaxis(c.reshape(b, nb, BLOCK, h), 1, 0)
    kpos = jnp.arange(s)

    def block_step(args):
        qi, ci, i = args
        sc = jnp.einsum('bqhd,bshd->bhqs', qi, k).astype(jnp.float32) * scale
        bias = jnp.transpose(ci, (0, 2, 1))[..., None] - c_keys[:, :, None, :]
        qpos = i * BLOCK + jnp.arange(BLOCK)
        causal = kpos[None, :] <= qpos[:, None]
        sc = jnp.where(causal[None, None], sc + bias, -jnp.inf)
        p = jax.nn.softmax(sc, axis=-1).astype(v.dtype)
        return jnp.einsum('bhqs,bshd->bqhd', p, v)

    out = lax.map(block_step, (qb, cb, jnp.arange(nb)))
    return jnp.moveaxis(out, 0, 1).reshape(b, s, h, d)


def setup_inputs(seed: int = 0) -> dict:
    key = jax.random.key(seed)
    ks = jax.random.split(key, 14)
    f32 = jnp.float32
    x = jax.random.normal(ks[0], (BATCH, SEQ, D_MODEL), f32)
    attn_norm_g = 1.0 + 0.02 * jax.random.normal(ks[1], (D_MODEL,), f32)
    w_in = jax.random.normal(ks[2], (D_MODEL, IN_WIDTH), f32) * D_MODEL ** -0.5
    b_forget = 2.0 + 0.5 * jax.random.normal(ks[3], (B_HEADS,), f32)
    q_norm_a = 1.0 + 0.02 * jax.random.normal(ks[4], (HEAD_DIM,), f32)
    k_norm_a = 1.0 + 0.02 * jax.random.normal(ks[5], (HEAD_DIM,), f32)
    sink_logits = 0.5 * jax.random.normal(ks[6], (A_HEADS,), f32)
    q_norm_b = 1.0 + 0.02 * jax.random.normal(ks[7], (HEAD_DIM,), f32)
    k_norm_b = 1.0 + 0.02 * jax.random.normal(ks[8], (HEAD_DIM,), f32)
    w_out = jax.random.normal(ks[9], (MIX_WIDTH, D_MODEL), f32) * MIX_WIDTH ** -0.5
    mlp_norm_g = 1.0 + 0.02 * jax.random.normal(ks[10], (D_MODEL,), f32)
    w_up = jax.random.normal(ks[11], (D_MODEL, D_FF), f32) * D_MODEL ** -0.5
    w_down = jax.random.normal(ks[12], (D_FF, D_MODEL), f32) * D_FF ** -0.5
    return {"x": x, "attn_norm_g": attn_norm_g, "w_in": w_in, "b_forget": b_forget,
            "q_norm_a": q_norm_a, "k_norm_a": k_norm_a, "sink_logits": sink_logits,
            "q_norm_b": q_norm_b, "k_norm_b": k_norm_b, "w_out": w_out,
            "mlp_norm_g": mlp_norm_g, "w_up": w_up, "w_down": w_down}


def reference(x, attn_norm_g, w_in, b_forget, q_norm_a, k_norm_a, sink_logits,
              q_norm_b, k_norm_b, w_out, mlp_norm_g, w_up, w_down):
    b, s, _ = x.shape
    for _layer in range(DEPTH):
        xn = rmsnorm(x, attn_norm_g)
        proj = jnp.einsum('bsd,de->bse', xn, w_in)
        qa, ka, va, qb, kb, vb, f_logit = jnp.split(proj, IN_SPLITS, axis=-1)
        qa = rmsnorm(qa.reshape(b, s, A_HEADS, HEAD_DIM), q_norm_a)
        ka = rmsnorm(ka.reshape(b, s, A_KV_HEADS, HEAD_DIM), k_norm_a)
        va = va.reshape(b, s, A_KV_HEADS, HEAD_DIM)
        out_a = swa_sinks_attention(qa, ka, va, sink_logits)
        qb = rmsnorm(qb.reshape(b, s, B_HEADS, HEAD_DIM), q_norm_b)
        kb = rmsnorm(kb.reshape(b, s, B_HEADS, HEAD_DIM), k_norm_b)
        vb = vb.reshape(b, s, B_HEADS, HEAD_DIM)
        log_f = jax.nn.log_sigmoid(f_logit.astype(jnp.float32) + b_forget.astype(jnp.float32))
        out_b = forgetting_attention(qb, kb, vb, log_f)
        mixed = jnp.concatenate([out_a.reshape(b, s, A_Q_W), out_b.reshape(b, s, B_W)], axis=-1)
        x = x + jnp.einsum('bse,ed->bsd', mixed, w_out)
        hn = rmsnorm(x, mlp_norm_g)
        hid = jnp.square(jax.nn.relu(jnp.einsum('bsd,df->bsf', hn, w_up)))
        x = x + jnp.einsum('bsf,fd->bsd', hid, w_down)
    return x
```

```cpp
#include <hip/hip_runtime.h>
#include <hip/hip_cooperative_groups.h>
#include <hip/hip_bf16.h>
#include <cstdio>
#include <cstdint>
#include <cmath>
namespace cg = cooperative_groups;
#ifndef PG8_WGM
#define PG8_WGM 8
#endif
namespace pg8 {
#define PG8_LAS __attribute__((address_space(3)))
typedef unsigned short bf16_t;
typedef short bf16x8 __attribute__((ext_vector_type(8)));
typedef float f32x4 __attribute__((ext_vector_type(4)));
typedef unsigned u32x4 __attribute__((ext_vector_type(4)));
constexpr int BM = 256, BK = 64, HALF = 128, HTB = HALF * BK * 2  , STAGE_BYTES = 8 * HTB, NXCD = 8, WGM = PG8_WGM;

__host__ __device__ __forceinline__ int lds_byte(int r, int c) { const int st = (r >> 4) * 2 + (c >> 5), rr = r & 15, cc = c & 31, ob = rr * 64 + cc * 2; return st * 1024 + (ob ^ (((ob >> 9) & 1) << 5)); }
__host__ __device__ __forceinline__ void stage_rc(int b, int& R, int& C) { const int st = b / 1024, sb = b % 1024, swz = sb ^ (((sb >> 9) & 1) << 5); R = (st >> 1) * 16 + swz / 64; C = (st & 1) * 32 + (swz % 64) / 2; }
__host__ __device__ __forceinline__ int perm32(int rho) { const int n = rho >> 4, i = rho & 15; return 8 * (i >> 2) + 4 * n + (i & 3); }

struct Unit { int pm, pn; };
struct Gemm { const bf16_t* A; const bf16_t* Bt; int M, N, K; };

struct StaticOrder {
    int nM, nN, nwg, G, c, wgm, rev;
    __host__ __device__ void init(int M, int N, int G_, int c_, int wgm_ = WGM, int rev_ = 0) { nM = M / BM; nN = N / BM; nwg = nM * nN; G = G_; c = c_; wgm = wgm_; rev = rev_; }
    __host__ __device__ bool next(int i, Unit& u) const {
        const int nr = (nwg + G - 1) / G; if (i >= nr) return false;
        const long L = (long)(rev ? nr - 1 - i : i) * G + c; if (L >= nwg) return false;
        int wgid = (int)L; { const int q = nwg / NXCD, r = nwg % NXCD, xcd = wgid % NXCD, off = wgid / NXCD; wgid = (xcd < r ? xcd * (q + 1) : r * (q + 1) + (xcd - r) * q) + off; }
        const int nig = wgm * nN, gid = wgid / nig, fm = gid * wgm, gsz = (nM - fm) < wgm ? (nM - fm) : wgm;
        u.pm = fm + ((wgid % nig) % gsz); u.pn = (wgid % nig) / gsz; return true;
    }
    __device__ __forceinline__ void a_ready(const Unit&) const {}
    __device__ __forceinline__ void done(const Unit&) const {}
};

__device__ __forceinline__ unsigned cvt_pk_bf16(float lo, float hi) { unsigned r; asm volatile("v_cvt_pk_bf16_f32 %0, %1, %2" : "=v"(r) : "v"(lo), "v"(hi)); return r; }
typedef float f32x2 __attribute__((ext_vector_type(2)));
#ifndef EPI_TOUCH_X
#define EPI_TOUCH_X false
#endif
#ifndef EPI_TOUCH_H
#define EPI_TOUCH_H false
#endif
#ifndef EPI_NT
#define EPI_NT 0
#endif
#if EPI_NT
#define NT_STORE16(p, v) __builtin_nontemporal_store((v), (u32x4*)(p))
#define NT_STOREF4(p, v) __builtin_nontemporal_store((v), (f32x4*)(p))
#else
#define NT_STORE16(p, v) (*(u32x4*)(p) = (v))
#define NT_STOREF4(p, v) (*(f32x4*)(p) = (v))
#endif
constexpr float EPI_C2 = 0.125f * 1.4426950408889634f;
constexpr int QKV_PITCH = 2304;
struct EpiInProj {
    static constexpr bool PERM = true, AFTER_DRAIN = false, TOUCH = false; static constexpr int REPS = 1;
    bf16_t* QKV; const float *qna, *kna, *qnb, *knb;
    __device__ __forceinline__ void operator()(const f32x4 (&acc)[2][2][4][2], const Unit& u, int wr, int wc, int fr, int fq) const {
        const int hs = u.pn * 4 + wc;
        const int row0 = u.pm * BM + wr * 64 + fr;
        const float* g = nullptr; float sc = 1.f;
        if (hs < 8) { g = qna; sc = EPI_C2; } else if (hs < 10) { g = kna; } else if (hs < 12) { } else if (hs < 20) { g = qnb; sc = EPI_C2; } else if (hs < 28) { g = knb; }
        f32x4 gv[2][2];
#pragma unroll
        for (int bj = 0; bj < 2; ++bj)
#pragma unroll
            for (int n = 0; n < 2; ++n) gv[bj][n] = g ? *(const f32x4*)(g + 32 * bj + 8 * fq + 4 * n) * sc : (f32x4){1.f, 1.f, 1.f, 1.f};
        bf16_t* base = QKV + hs * 64 + 8 * fq;
#pragma unroll
        for (int ai = 0; ai < 2; ++ai)
#pragma unroll
            for (int m = 0; m < 4; ++m) { const int row = row0 + ai * HALF + m * 16;
                float rinv = 1.f;
                if (g) { float ss = 0.f;
#pragma unroll
                    for (int bj = 0; bj < 2; ++bj)
#pragma unroll
                        for (int n = 0; n < 2; ++n) { const f32x4 v = acc[ai][bj][m][n]; ss += (v[0] * v[0] + v[1] * v[1]) + (v[2] * v[2] + v[3] * v[3]); }
                    ss += __shfl_xor(ss, 16); ss += __shfl_xor(ss, 32);
                    rinv = rsqrtf(ss * (1.f / 64.f) + 1e-6f); }
#pragma unroll
                for (int bj = 0; bj < 2; ++bj) { const f32x4 v0 = acc[ai][bj][m][0] * rinv * gv[bj][0], v1 = acc[ai][bj][m][1] * rinv * gv[bj][1];
                    u32x4 w; w.x = cvt_pk_bf16(v0[0], v0[1]); w.y = cvt_pk_bf16(v0[2], v0[3]); w.z = cvt_pk_bf16(v1[0], v1[1]); w.w = cvt_pk_bf16(v1[2], v1[3]);
                    *(u32x4*)(base + (size_t)row * QKV_PITCH + 32 * bj) = w; } }
    }
};
struct EpiOutProj {
    static constexpr bool PERM = true, AFTER_DRAIN = false, TOUCH = EPI_TOUCH_X; static constexpr int REPS = 1;
    const float* x; bf16_t* hb; float* part; PG8_LAS float* red;
    __device__ __forceinline__ void touch(const Unit& u, int tid, unsigned& reg) const {
        const char* p = (const char*)(x + (size_t)(u.pm * BM + (tid & 255)) * 1024 + u.pn * BM) + (tid >> 8) * 512;
#pragma unroll
        for (int l = 0; l < 4; ++l) asm volatile("global_load_dword %0, %1, off offset:%c2" : "+v"(reg) : "v"(p), "i"(l * 128) : "memory");
    }
    __device__ __forceinline__ void operator()(const f32x4 (&acc)[2][2][4][2], const Unit& u, int wr, int wc, int fr, int fq) const {
        const int row0 = u.pm * BM + wr * 64 + fr, col0 = u.pn * BM + wc * 32 + 8 * fq;
#pragma unroll
        for (int ai = 0; ai < 2; ++ai) {
            f32x4 xr[4][2][2];
#pragma unroll
            for (int m = 0; m < 4; ++m) { const size_t off = (size_t)(row0 + ai * HALF + m * 16) * 1024 + col0;
#pragma unroll
                for (int bj = 0; bj < 2; ++bj) { xr[m][bj][0] = *(const f32x4*)(x + off + bj * HALF); xr[m][bj][1] = *(const f32x4*)(x + off + bj * HALF + 4); } }
#pragma unroll
            for (int m = 0; m < 4; ++m) { const int row = row0 + ai * HALF + m * 16; const size_t off = (size_t)row * 1024 + col0; float ss = 0.f;
#pragma unroll
                for (int bj = 0; bj < 2; ++bj) { const f32x4 v0 = acc[ai][bj][m][0] + xr[m][bj][0], v1 = acc[ai][bj][m][1] + xr[m][bj][1];
                    u32x4 w; w.x = cvt_pk_bf16(v0[0], v0[1]); w.y = cvt_pk_bf16(v0[2], v0[3]); w.z = cvt_pk_bf16(v1[0], v1[1]); w.w = cvt_pk_bf16(v1[2], v1[3]);
                    *(u32x4*)(hb + off + bj * HALF) = w;
                    ss += (v0[0] * v0[0] + v0[1] * v0[1]) + (v0[2] * v0[2] + v0[3] * v0[3]) + (v1[0] * v1[0] + v1[1] * v1[1]) + (v1[2] * v1[2] + v1[3] * v1[3]); }
                ss += __shfl_xor(ss, 16); ss += __shfl_xor(ss, 32);
                if (fq == 0) red[(ai * HALF + wr * 64 + m * 16 + fr) * 4 + wc] = ss; } }
        asm volatile("s_waitcnt lgkmcnt(0)" ::: "memory"); __builtin_amdgcn_s_barrier(); asm volatile("" ::: "memory");
        const int t = (wr * 4 + wc) * 64 + fq * 16 + fr;
        if (t < BM) { const f32x4 p = *(const PG8_LAS f32x4*)(red + t * 4); part[(size_t)(u.pm * BM + t) * 4 + u.pn] = (p[0] + p[1]) + (p[2] + p[3]); }
    }
};
struct EpiUp {
    static constexpr bool PERM = true, AFTER_DRAIN = false, TOUCH = false;
#ifdef REP_EPI_UP
    static constexpr int REPS = REP_EPI_UP;
#else
    static constexpr int REPS = 1;
#endif
    bf16_t* hid; const float* rowss;
    __device__ __forceinline__ void operator()(const f32x4 (&acc)[2][2][4][2], const Unit& u, int wr, int wc, int fr, int fq) const {
        const int row0 = u.pm * BM + wr * 64 + fr, col0 = u.pn * BM + wc * 32 + 8 * fq;
        float rs[2][4];
#pragma unroll
        for (int ai = 0; ai < 2; ++ai)
#pragma unroll
            for (int m = 0; m < 4; ++m) { const f32x4 pp = *(const f32x4*)(rowss + (size_t)(row0 + ai * HALF + m * 16) * 4); rs[ai][m] = (pp[0] + pp[1]) + (pp[2] + pp[3]); }
#pragma unroll
        for (int ai = 0; ai < 2; ++ai)
#pragma unroll
            for (int m = 0; m < 4; ++m) { const int row = row0 + ai * HALF + m * 16; const float r = rsqrtf(rs[ai][m] * (1.f / 1024.f) + 1e-6f);
                bf16_t* rowp = hid + (size_t)row * 4096 + col0;
#pragma unroll
                for (int bj = 0; bj < 2; ++bj) { f32x4 v0 = acc[ai][bj][m][0] * r, v1 = acc[ai][bj][m][1] * r;
#pragma unroll
                    for (int j = 0; j < 4; ++j) { v0[j] = fmaxf(v0[j], 0.f); v1[j] = fmaxf(v1[j], 0.f); }
                    v0 = v0 * v0; v1 = v1 * v1;
                    u32x4 w; w.x = cvt_pk_bf16(v0[0], v0[1]); w.y = cvt_pk_bf16(v0[2], v0[3]); w.z = cvt_pk_bf16(v1[0], v1[1]); w.w = cvt_pk_bf16(v1[2], v1[3]);
                    NT_STORE16(rowp + bj * HALF, w); } }
    }
};
struct EpiDown {
    static constexpr bool PERM = true, AFTER_DRAIN = false, TOUCH = EPI_TOUCH_H; static constexpr int REPS = 1;
    const bf16_t* hb; float* out;
    __device__ __forceinline__ void touch(const Unit& u, int tid, unsigned& reg) const {
        const char* p = (const char*)(hb + (size_t)(u.pm * BM + (tid & 255)) * 1024 + u.pn * BM) + (tid >> 8) * 256;
#pragma unroll
        for (int l = 0; l < 2; ++l) asm volatile("global_load_dword %0, %1, off offset:%c2" : "+v"(reg) : "v"(p), "i"(l * 128) : "memory");
    }
    __device__ __forceinline__ void operator()(const f32x4 (&acc)[2][2][4][2], const Unit& u, int wr, int wc, int fr, int fq) const {
        const int row0 = u.pm * BM + wr * 64 + fr, col0 = u.pn * BM + wc * 32 + 8 * fq;
        u32x4 hr[2][4][2];
#pragma unroll
        for (int ai = 0; ai < 2; ++ai)
#pragma unroll
            for (int m = 0; m < 4; ++m)
#pragma unroll
                for (int bj = 0; bj < 2; ++bj) hr[ai][m][bj] = *(const u32x4*)(hb + (size_t)(row0 + ai * HALF + m * 16) * 1024 + col0 + bj * HALF);
#pragma unroll
        for (int ai = 0; ai < 2; ++ai)
#pragma unroll
            for (int m = 0; m < 4; ++m) { float* rowp = out + (size_t)(row0 + ai * HALF + m * 16) * 1024 + col0;
#pragma unroll
                for (int bj = 0; bj < 2; ++bj) { const u32x4 h = hr[ai][m][bj];
                    const f32x4 a = {__builtin_bit_cast(float, h.x << 16), __builtin_bit_cast(float, h.x & 0xffff0000u), __builtin_bit_cast(float, h.y << 16), __builtin_bit_cast(float, h.y & 0xffff0000u)};
                    const f32x4 b = {__builtin_bit_cast(float, h.z << 16), __builtin_bit_cast(float, h.z & 0xffff0000u), __builtin_bit_cast(float, h.w << 16), __builtin_bit_cast(float, h.w & 0xffff0000u)};
                    NT_STOREF4(rowp + bj * HALF, a + acc[ai][bj][m][0]); NT_STOREF4(rowp + bj * HALF + 4, b + acc[ai][bj][m][1]); } }
    }
};
template <class Epi, class Sched, bool ALIGN_EPI = false, bool SP2 = false, int NARROW_PN = -1, bool PF = false>
__device__ __forceinline__ void gemm_phase(PG8_LAS unsigned char* lds, const Gemm g, const Sched& S, const Epi& E) {
    int tid_l = threadIdx.x; asm volatile("" : "+v"(tid_l));
    const int tid = tid_l, wid = __builtin_amdgcn_readfirstlane(tid >> 6), lane = tid & 63, wr = wid >> 2, wc = wid & 3, fr = lane & 15, fq = lane >> 4;
    const int K = g.K, nt = K / BK;
    unsigned voffA[2], voffB[2];
#pragma unroll
    for (int i = 0; i < 2; ++i) { int R, C; stage_rc(tid * 16 + i * 8192, R, C); const int Rb = Epi::PERM ? ((R & ~31) + perm32(R & 31)) : R;
        voffA[i] = (unsigned)(R * K + C) * 2u; voffB[i] = (unsigned)(Rb * K + C) * 2u; }
    const size_t kstep = (size_t)(BK * 2);
    const size_t hstep = (size_t)HALF * K * 2;
    const size_t tstep = 2 * hstep;
    unsigned pfreg = 0u; const unsigned pfoff = (unsigned)(tid & 255) * (unsigned)K * 2u; const bool pfB = wid >= 4;
    const unsigned ldsw = (unsigned)wid * 1024u;
    const int aoff = lds_byte(wr * 64 + fr, fq * 8), boff = lds_byte(wc * 32 + fr, fq * 8);
#define PG8_SA(b, h) (((b) * 2 + (h)) * HTB)
#define PG8_SB(b, h) ((4 + (b) * 2 + (h)) * HTB)
#define PG8_STAGE(bufoff, gbase, voff) do { _Pragma("unroll") for (int _i = 0; _i < 2; ++_i) \
        __builtin_amdgcn_global_load_lds((const unsigned*)((const char*)(gbase) + (voff)[_i]), (PG8_LAS unsigned*)(lds + (bufoff) + ldsw + _i * 8192), 16, 0, 0); } while (0)
#define PG8_LDA(dst, b, h) do { _Pragma("unroll") for (int m = 0; m < 4; ++m) _Pragma("unroll") for (int k = 0; k < 2; ++k) dst[m][k] = *(const PG8_LAS bf16x8*)(lds + PG8_SA(b, h) + aoff + m * 2048 + k * 1024); } while (0)
#define PG8_LDB(dst, b, h) do { _Pragma("unroll") for (int n = 0; n < 2; ++n) _Pragma("unroll") for (int k = 0; k < 2; ++k) dst[n][k] = *(const PG8_LAS bf16x8*)(lds + PG8_SB(b, h) + boff + n * 2048 + k * 1024); } while (0)
#define PG8_MMA(ai, bj, At, Bt) do { __builtin_amdgcn_s_setprio(1); _Pragma("unroll") for (int m = 0; m < 4; ++m) _Pragma("unroll") for (int n = 0; n < 2; ++n) _Pragma("unroll") for (int k = 0; k < 2; ++k) \
        acc[ai][bj][m][n] = __builtin_amdgcn_mfma_f32_16x16x32_bf16(Bt[n][k], At[m][k], acc[ai][bj][m][n], 0, 0, 0); __builtin_amdgcn_s_setprio(0); } while (0)
#define PG8_WAIT_V(n) asm volatile("s_waitcnt vmcnt(" #n ")" ::: "memory")
#define PG8_WAIT_VL() do { if constexpr (PF) PG8_WAIT_V(9); else PG8_WAIT_V(8); } while (0)
#define PG8_PF(kt) do { if constexpr (PF) { const int k_ = (kt); const char* base_ = k_ < nt ? (pfB ? cB : cA) + (size_t)k_ * kstep : (pfB ? nB : nA) + (size_t)(k_ - nt) * kstep; \
        asm volatile("global_load_dword %0, %1, off" : "+v"(pfreg) : "v"(base_ + pfoff) : "memory"); } } while (0)
#define PG8_WAIT_L(n) asm volatile("s_waitcnt lgkmcnt(" #n ")" ::: "memory")
#define PG8_BAR __builtin_amdgcn_s_barrier()
#define PG8_SCHED __builtin_amdgcn_sched_barrier(0)
    Unit cur, nxt; int ui = 0;
    if (!S.next(0, cur)) return;
    f32x4 acc[2][2][4][2];
#pragma unroll
    for (int a = 0; a < 2; ++a)
#pragma unroll
        for (int b = 0; b < 2; ++b)
#pragma unroll
            for (int m = 0; m < 4; ++m)
#pragma unroll
                for (int n = 0; n < 2; ++n) acc[a][b][m][n] = (f32x4){0.f, 0.f, 0.f, 0.f};
    bf16x8 At[4][2], B0[2][2], B1[2][2];
    const char* cA = (const char*)g.A + (size_t)cur.pm * tstep; const char* cB = (const char*)g.Bt + (size_t)cur.pn * tstep;
    S.a_ready(cur);
    if constexpr (SP2) {
        PG8_STAGE(PG8_SB(0, 0), cB, voffB); PG8_STAGE(PG8_SB(0, 1), cB + hstep, voffB); PG8_STAGE(PG8_SA(0, 0), cA, voffA); PG8_STAGE(PG8_SA(0, 1), cA + hstep, voffA);
        if (wr == 1) PG8_BAR;
        PG8_WAIT_V(2); PG8_BAR;
        PG8_STAGE(PG8_SB(1, 0), cB + kstep, voffB); PG8_STAGE(PG8_SA(1, 0), cA + kstep, voffA); PG8_STAGE(PG8_SB(1, 1), cB + hstep + kstep, voffB);
        PG8_WAIT_V(6); PG8_BAR;
    } else {
        PG8_STAGE(PG8_SB(0, 0), cB, voffB); PG8_STAGE(PG8_SA(0, 0), cA, voffA); PG8_STAGE(PG8_SB(0, 1), cB + hstep, voffB); PG8_STAGE(PG8_SA(0, 1), cA + hstep, voffA);
        if (wr == 1) PG8_BAR;
        PG8_WAIT_V(4); PG8_BAR;
        PG8_STAGE(PG8_SB(1, 0), cB + kstep, voffB); PG8_STAGE(PG8_SA(1, 0), cA + kstep, voffA); PG8_STAGE(PG8_SB(1, 1), cB + hstep + kstep, voffB);
        PG8_WAIT_V(6); PG8_BAR;
    }
    for (;;) {
        const bool has_next = S.next(ui + 1, nxt);
        if constexpr (Epi::TOUCH) E.touch(cur, tid, pfreg);
        const char* nA = has_next ? (const char*)g.A + (size_t)nxt.pm * tstep : cA; const char* nB = has_next ? (const char*)g.Bt + (size_t)nxt.pn * tstep : cB;
        const bool narrow = NARROW_PN >= 0 && cur.pn == NARROW_PN;
        for (int t = 0; t < nt; t += 2) {
            const bool last = (t == nt - 2);
            const char* a1 = cA + (size_t)(t + 1) * kstep;
            const char* a2 = last ? nA : cA + (size_t)(t + 2) * kstep; const char* b2 = last ? nB : cB + (size_t)(t + 2) * kstep;
            const char* a3 = a2 + kstep; const char* b3 = b2 + kstep;
            if (last && has_next) S.a_ready(nxt);
            if constexpr (SP2) {
            PG8_LDB(B0, 0, 0); PG8_LDB(B1, 0, 1); PG8_SCHED; PG8_LDA(At, 0, 0); PG8_STAGE(PG8_SA(1, 1), a1 + hstep, voffA); PG8_PF(t + 4);
            PG8_WAIT_VL(); PG8_WAIT_L(0); PG8_BAR; PG8_MMA(0, 0, At, B0); if (!narrow) PG8_MMA(0, 1, At, B1); PG8_BAR; PG8_SCHED;
            PG8_LDA(At, 0, 1); PG8_STAGE(PG8_SB(0, 0), b2, voffB); PG8_STAGE(PG8_SB(0, 1), b2 + hstep, voffB); PG8_STAGE(PG8_SA(0, 0), a2, voffA);
            PG8_WAIT_VL(); PG8_WAIT_L(0); PG8_BAR; PG8_MMA(1, 0, At, B0); if (!narrow) PG8_MMA(1, 1, At, B1); PG8_BAR; PG8_SCHED;
            PG8_LDB(B0, 1, 0); PG8_LDB(B1, 1, 1); PG8_SCHED; PG8_LDA(At, 1, 0); PG8_STAGE(PG8_SA(0, 1), a2 + hstep, voffA); PG8_PF(t + 5);
            PG8_WAIT_VL(); PG8_WAIT_L(0); PG8_BAR; PG8_MMA(0, 0, At, B0); if (!narrow) PG8_MMA(0, 1, At, B1); PG8_BAR; PG8_SCHED;
            PG8_LDA(At, 1, 1); PG8_STAGE(PG8_SB(1, 0), b3, voffB); PG8_STAGE(PG8_SB(1, 1), b3 + hstep, voffB); PG8_STAGE(PG8_SA(1, 0), a3, voffA);
            PG8_WAIT_VL(); PG8_WAIT_L(0); PG8_BAR; PG8_MMA(1, 0, At, B0); if (!narrow) PG8_MMA(1, 1, At, B1); PG8_BAR; PG8_SCHED;
            } else {
            PG8_LDB(B0, 0, 0); PG8_SCHED; PG8_LDA(At, 0, 0); PG8_STAGE(PG8_SA(1, 1), a1 + hstep, voffA);
            PG8_WAIT_L(8); PG8_BAR; PG8_WAIT_L(0); PG8_MMA(0, 0, At, B0); PG8_BAR; PG8_SCHED;
            PG8_LDB(B1, 0, 1); PG8_STAGE(PG8_SB(0, 0), b2, voffB);
            PG8_BAR; PG8_WAIT_L(0); PG8_MMA(0, 1, At, B1); PG8_BAR;
            PG8_LDA(At, 0, 1); PG8_STAGE(PG8_SA(0, 0), a2, voffA);
            PG8_BAR; PG8_WAIT_L(0); PG8_MMA(1, 0, At, B0); PG8_BAR; PG8_SCHED;
            PG8_STAGE(PG8_SB(0, 1), b2 + hstep, voffB);
            PG8_WAIT_V(6); PG8_BAR; PG8_MMA(1, 1, At, B1); PG8_BAR;
            PG8_LDB(B0, 1, 0); PG8_SCHED; PG8_LDA(At, 1, 0); PG8_STAGE(PG8_SA(0, 1), a2 + hstep, voffA);
            PG8_WAIT_L(8); PG8_BAR; PG8_WAIT_L(0); PG8_MMA(0, 0, At, B0); PG8_BAR; PG8_SCHED;
            PG8_LDB(B1, 1, 1); PG8_STAGE(PG8_SB(1, 0), b3, voffB);
            PG8_BAR; PG8_WAIT_L(0); PG8_MMA(0, 1, At, B1); PG8_BAR;
            PG8_LDA(At, 1, 1); PG8_STAGE(PG8_SA(1, 0), a3, voffA);
            PG8_BAR; PG8_WAIT_L(0); PG8_MMA(1, 0, At, B0); PG8_BAR; PG8_SCHED;
            PG8_STAGE(PG8_SB(1, 1), b3 + hstep, voffB);
            PG8_WAIT_V(6); PG8_BAR; PG8_MMA(1, 1, At, B1); PG8_BAR;
            }
        }
        if constexpr (ALIGN_EPI) { if (wr == 0) PG8_BAR; }
        if constexpr (!Epi::AFTER_DRAIN) { for (int er = 0; er < Epi::REPS; ++er) E(acc, cur, wr, wc, fr, fq); S.done(cur); }
        if (!has_next) break;
#pragma unroll
        for (int a = 0; a < 2; ++a)
#pragma unroll
            for (int b = 0; b < 2; ++b)
#pragma unroll
                for (int m = 0; m < 4; ++m)
#pragma unroll
                    for (int n = 0; n < 2; ++n) acc[a][b][m][n] = (f32x4){0.f, 0.f, 0.f, 0.f};
        cur = nxt; cA = nA; cB = nB; ++ui;
        if constexpr (ALIGN_EPI) { if (wr == 1) PG8_BAR; }
    }
    PG8_WAIT_V(0);
    asm volatile("" :: "v"(pfreg));
    if constexpr (!ALIGN_EPI) { if (wr == 0) PG8_BAR; }
    PG8_BAR;
    if constexpr (Epi::AFTER_DRAIN) { E.fused(acc, cur, wr, wc, fr, fq, lds, wid, lane); S.done(cur); }
#undef PG8_SA
#undef PG8_SB
#undef PG8_STAGE
#undef PG8_LDA
#undef PG8_LDB
#undef PG8_MMA
#undef PG8_WAIT_V
#undef PG8_WAIT_VL
#undef PG8_PF
#undef PG8_WAIT_L
#undef PG8_BAR
#undef PG8_SCHED
}
}
#include <hip/hip_bf16.h>
#include <cmath>
namespace attn_body {
using bf16=__hip_bfloat16;
using bf16x8=__attribute__((ext_vector_type(8)))short;
using s16x4=__attribute__((ext_vector_type(4)))short;
using f32x16=__attribute__((ext_vector_type(16)))float;
using u32x4=__attribute__((ext_vector_type(4)))unsigned;
using f32x4_t=__attribute__((ext_vector_type(4)))float;
constexpr int SEQ=4096,D=64,DM=2304,OPITCH=1024;
constexpr int NW=8,QBLK=32,QB=QBLK*NW,KVBLK=64,NQB=SEQ/QB;
constexpr int ATTN_PITCH=DM, ATTN_UNIT_ROWS=QB;
__device__ __forceinline__ int crow(int r,int hi){return (r&3)+8*(r>>2)+4*hi;}
#define SBAR() __builtin_amdgcn_sched_barrier(0)
template<bool WIN> __device__ __forceinline__ void cmask(f32x16&p0,f32x16&p1,int jb,int qrel,int hi,int q0){
  const float NEG=-INFINITY; int kb=64*jb+4*hi-(WIN?128:0);
  #pragma unroll
  for(int r=0;r<16;++r){int kv=kb+(r&3)+8*(r>>2); if(kv>qrel||(WIN&&(kv<=qrel-128||kv<-q0)))p0[r]=NEG; if(kv+32>qrel||(WIN&&(kv+32<=qrel-128||kv+32<-q0)))p1[r]=NEG;}
}

constexpr int NSLOT=3, SLOTB=8192;
constexpr int LDS_K=0, LDS_V=NSLOT*SLOTB, LDS_WS=2*NSLOT*SLOTB, LDS_OST=LDS_WS+NW*64*4, LDS_CS=LDS_OST+NW*4096, LDS_BYTES=LDS_CS+SEQ*4;
constexpr float C2=0.125f*1.4426950408889634f;
__device__ __forceinline__ void glds16(const void*gsrc,unsigned lds_dst){unsigned keep;
  asm volatile("s_mov_b32 %0, m0\n\ts_mov_b32 m0, %2\n\ts_nop 0\n\tglobal_load_lds_dwordx4 %1, off\n\ts_mov_b32 m0, %0":"=&s"(keep):"v"(gsrc),"s"(lds_dst):"memory");}
__device__ __forceinline__ float max3f(float a,float b,float c){float r;asm("v_max3_f32 %0, %1, %2, %3":"=v"(r):"v"(a),"v"(b),"v"(c));return r;}
__device__ __forceinline__ float max2f(float a,float b){float r;asm("v_max_f32_e32 %0, %1, %2":"=v"(r):"v"(a),"v"(b));return r;}
__device__ __forceinline__ float fadd_s(float a,float b){float r;asm("v_add_f32_e32 %0, %1, %2":"=v"(r):"v"(a),"v"(b));return r;}
__device__ __forceinline__ float fsub_s(float a,float b){float r;asm("v_sub_f32_e32 %0, %1, %2":"=v"(r):"v"(a),"v"(b));return r;}
typedef float f32x2_t __attribute__((ext_vector_type(2))); typedef __bf16 bf16x2_t __attribute__((ext_vector_type(2)));
__device__ __forceinline__ unsigned cvtpk_s(float lo,float hi){f32x2_t v={lo,hi};bf16x2_t b=__builtin_convertvector(v,bf16x2_t);return __builtin_bit_cast(unsigned,b);}
#define WAIT_BAR(N) asm volatile("s_waitcnt vmcnt(" #N ") lgkmcnt(0)\n\ts_barrier":::"memory")

__device__ __forceinline__ void qkt(f32x16&p0,f32x16&p1,const char*Kslot,const bf16x8*qr,int r32,int hi){
  const char*kb=Kslot+hi*1024+r32*16;
  #pragma unroll
  for(int d0=0;d0<4;++d0){
    const bf16x8 b0=*reinterpret_cast<const bf16x8*>(kb+d0*2048);
    const bf16x8 b1=*reinterpret_cast<const bf16x8*>(kb+d0*2048+512);
    p0=__builtin_amdgcn_mfma_f32_32x32x16_bf16(b0,qr[d0],p0,0,0,0);p1=__builtin_amdgcn_mfma_f32_32x32x16_bf16(b1,qr[d0],p1,0,0,0);}
}
typedef __attribute__((address_space(3))) const char* lds_cptr;
typedef short v4i16_t __attribute__((ext_vector_type(4)));
__device__ __forceinline__ void kload8(bf16x8*kf,lds_cptr kp){
  kf[0]=*(const __attribute__((address_space(3))) bf16x8*)(kp);      kf[1]=*(const __attribute__((address_space(3))) bf16x8*)(kp+512);
  kf[2]=*(const __attribute__((address_space(3))) bf16x8*)(kp+2048); kf[3]=*(const __attribute__((address_space(3))) bf16x8*)(kp+2560);
  kf[4]=*(const __attribute__((address_space(3))) bf16x8*)(kp+4096); kf[5]=*(const __attribute__((address_space(3))) bf16x8*)(kp+4608);
  kf[6]=*(const __attribute__((address_space(3))) bf16x8*)(kp+6144); kf[7]=*(const __attribute__((address_space(3))) bf16x8*)(kp+6656);
}
__device__ __forceinline__ void kload2(bf16x8*kf,lds_cptr kp,int j){ kf[2*j]=*(const __attribute__((address_space(3))) bf16x8*)(kp+j*2048); kf[2*j+1]=*(const __attribute__((address_space(3))) bf16x8*)(kp+j*2048+512); }
__device__ __forceinline__ s16x4 vtr(lds_cptr p){ return __builtin_bit_cast(s16x4,__builtin_amdgcn_ds_read_tr16_b64_v4i16((__attribute__((address_space(3))) v4i16_t*)p)); }
__device__ __forceinline__ float rowmax(const f32x16&p0,const f32x16&p1){
  float a=max3f(p0[0],p0[1],p1[0]),b=max3f(p0[2],p0[3],p1[1]);a=max3f(a,p1[2],p1[3]);
  #pragma unroll
  for(int r=4;r<16;r+=4){a=max3f(a,p0[r],p0[r+1]);b=max3f(b,p0[r+2],p0[r+3]);a=max3f(a,p1[r],p1[r+1]);b=max3f(b,p1[r+2],p1[r+3]);}
  const float m=max2f(a,b);
  auto rr=__builtin_amdgcn_permlane32_swap(__float_as_uint(m),__float_as_uint(m),false,false);
  return max2f(__uint_as_float(rr[0]),__uint_as_float(rr[1]));
}
__device__ __forceinline__ void pv(f32x16*o,int vb,bf16x8 pa0,bf16x8 pa1,bf16x8 pa2,bf16x8 pa3){
  #pragma unroll
  for(int d0=0;d0<2;++d0){s16x4 lo[4],hi[4];
    #pragma unroll
    for(int ks=0;ks<4;++ks){
      asm volatile("ds_read_b64_tr_b16 %0,%1 offset:%c2":"=&v"(lo[ks]):"v"(vb),"i"(d0*4096+ks*1024):"memory");
      asm volatile("ds_read_b64_tr_b16 %0,%1 offset:%c2":"=&v"(hi[ks]):"v"(vb),"i"(d0*4096+ks*1024+512):"memory");}
    asm volatile("s_waitcnt lgkmcnt(0)":::"memory");SBAR();
    #define PK(k) (bf16x8){lo[k][0],lo[k][1],lo[k][2],lo[k][3],hi[k][0],hi[k][1],hi[k][2],hi[k][3]}
    o[d0]=__builtin_amdgcn_mfma_f32_32x32x16_bf16(pa0,PK(0),o[d0],0,0,0);
    o[d0]=__builtin_amdgcn_mfma_f32_32x32x16_bf16(pa1,PK(1),o[d0],0,0,0);
    o[d0]=__builtin_amdgcn_mfma_f32_32x32x16_bf16(pa2,PK(2),o[d0],0,0,0);
    o[d0]=__builtin_amdgcn_mfma_f32_32x32x16_bf16(pa3,PK(3),o[d0],0,0,0);
    #undef PK
  }
}

#ifndef ATTN_STORE16
#define ATTN_STORE16(p,v) (*(u32x4*)(p)=(v))
#endif
struct AttnNext{int has,b,qb,qcol,kcol,vcol;};
template<int THRL,bool WIN> __device__ __forceinline__ void attn_unit(int b,int qb,int j0,int qcol,int kcol,int vcol,int ocol,const bf16*QKV,bf16*O,const float*cseq,float slope2,float sink2,float sink2b,
    int s0,bool head_done,bf16x8 (&qr)[4],const AttnNext nx,unsigned nxt_ticket,volatile __attribute__((address_space(3))) unsigned*qslot,const int*j0tab,const float*call,float&ctm_io,int&o_s0,unsigned&o_tk,int&o_j0,char*shm){
  int tid_l=threadIdx.x; asm volatile("":"+v"(tid_l));
  const int tid=tid_l,lane=tid&63,r32=lane&31,hi=lane>>5; const int wid=__builtin_amdgcn_readfirstlane(tid>>6);
  const long rowbase=(long)b*SEQ; const int q0=qb*(WIN?128:QB);
  const int wrow=WIN?(wid&3)*QBLK:wid*QBLK, hs=WIN?(wid>>2):0;
  const float slope2w=hs?0.5f*slope2:slope2;
  const bf16*Qw=QKV+(rowbase+q0+wrow)*DM+qcol+hs*D;
  const bf16*Kh=QKV+(rowbase+j0*KVBLK)*DM+kcol,*Vh=QKV+(rowbase+j0*KVBLK)*DM+vcol;
  const int qrel=wrow+r32;
  const int NT=(q0+(WIN?128:QB))/KVBLK-j0;
  typedef __attribute__((address_space(3))) float* lds_fptr; typedef __attribute__((address_space(3))) const f32x4_t* lds_f4ptr;
  const lds_fptr csl=(lds_fptr)(shm+LDS_CS);
  float ctm;
  const unsigned lds0=(unsigned)(uintptr_t)shm;
  float*wsf=(float*)(shm+LDS_WS)+wid*64;
  const bf16*ksrc=Kh+(long)lane*DM+wid*8;
  const bf16*vsrc=Vh+(long)(16*(wid&3)+(lane>>2))*DM+(wid>>2)*32+(lane&3)*8;
  const unsigned kdst=lds0+LDS_K+wid*1024, vdst=lds0+LDS_V+wid*1024;
  #define DMA_K(t,slot) glds16(ksrc+(long)(t)*KVBLK*DM,(unsigned)__builtin_amdgcn_readfirstlane(kdst+(slot)))
  #define DMA_V(t,slot) glds16(vsrc+(long)(t)*KVBLK*DM,(unsigned)__builtin_amdgcn_readfirstlane(vdst+(slot)))
  const int vb0=(int)(lds0+LDS_V)+((lane>>4)&1)*32+(lane&3)*8+(4*hi+((lane&15)>>2))*64;
  const char*Kbase=shm+LDS_K; bf16x8 kf[8];
  const lds_cptr shm3=(lds_cptr)shm; const lds_cptr kp0=shm3+LDS_K+hi*1024+r32*16; const lds_cptr vp0=shm3+LDS_V+((lane>>4)&1)*32+(lane&3)*8+(4*hi+((lane&15)>>2))*64;
  #define NEXTS(s) (((s)==(NSLOT-1)*SLOTB)?0:(s)+SLOTB)
  const int s1=NEXTS(s0),s2=NEXTS(s1);
  if(!head_done){DMA_K(0,s0);DMA_V(0,s0);DMA_K(1,s1);}
  if(WIN||!head_done){
  #pragma unroll
  for(int d0=0;d0<4;++d0)qr[d0]=*reinterpret_cast<const bf16x8*>(&Qw[(long)r32*DM+d0*16+hi*8]);}
  float mhat=0.f,l_reg=0.f;f32x16 o[2];o[0]=f32x16{};o[1]=f32x16{};
  #define CMASK(P0,P1,t) do{int jb_=(t)-(NT-4); if(WIN||jb_>=0)cmask<WIN>(P0,P1,jb_,qrel,hi,q0);}while(0)
  bool resc=false;
  #define START(P0,P1) do{ const float rm=rowmax(P0,P1); resc=false; \
    if(__any(rm>(float)THRL)){ const float dl=__builtin_fmaxf(rm,0.f); mhat+=dl; ctm-=dl; \
      _Pragma("unroll") for(int r=0;r<16;++r){P0[r]-=dl;P1[r]-=dl;} } \
    _Pragma("unroll") for(int r=0;r<16;++r)P0[r]=__builtin_amdgcn_exp2f(P0[r]); }while(0)
  #define BIASLD(P0,P1,tt) do{ const lds_f4ptr cp_=(lds_f4ptr)(csl+(tt)*KVBLK+4*hi); \
    _Pragma("unroll") for(int g_=0;g_<4;++g_){ const f32x4_t a_=cp_[2*g_], b_=cp_[8+2*g_]; \
      P0[4*g_]=a_[0];P0[4*g_+1]=a_[1];P0[4*g_+2]=a_[2];P0[4*g_+3]=a_[3]; P1[4*g_]=b_[0];P1[4*g_+1]=b_[1];P1[4*g_+2]=b_[2];P1[4*g_+3]=b_[3]; } }while(0)
  #define BS(x) (WIN?__builtin_fmaf(slope2w,(x),ctm):ctm-(x))
  #define BIASSUB(P0,P1) do{ _Pragma("unroll") for(int r=0;r<16;++r){P0[r]=BS(P0[r]);P1[r]=BS(P1[r]);} }while(0)
  #define RESC() do{ if(resc){ asm volatile("s_waitcnt lgkmcnt(0)":::"memory"); \
      _Pragma("unroll") for(int d_=0;d_<2;++d_) _Pragma("unroll") for(int r=0;r<16;++r)o[d_][r]*=wsf[crow(r,hi)]; } }while(0)
  f32x16 pA0,pA1,pB0,pB1;
  int sl_prev=s0,sl_cur=s0,sl_next=s1;
  #define ROT() do{sl_prev=sl_cur;sl_cur=sl_next;sl_next=(sl_next==(NSLOT-1)*SLOTB)?0:sl_next+SLOTB;}while(0)
  if(!head_done)DMA_K(2,s2);
  if(WIN){ if(!head_done){for(int k=tid;k<NT*KVBLK;k+=NW*64)csl[k]=(float)(k-128);} ctm=-slope2w*(float)qrel; }
  else if(head_done){ ctm=ctm_io; }
  else{ float cv[8]; const int nk=NT*KVBLK;
    #pragma unroll
    for(int i=0;i<8;++i){const int k=tid+i*NW*64; cv[i]=cseq[j0*KVBLK+(k<nk?k:0)];}
    ctm=cseq[q0+qrel];
    #pragma unroll
    for(int i=0;i<8;++i){const int k=tid+i*NW*64; if(k<nk)csl[k]=cv[i];} }
  WAIT_BAR(3);
  if(!WIN&&tid==0)*qslot=nxt_ticket;
  BIASLD(pA0,pA1,0); BIASSUB(pA0,pA1);
  qkt(pA0,pA1,Kbase+s0,qr,r32,hi);asm volatile("s_nop 15\n\ts_nop 7":"+v"(pA0),"+v"(pA1));CMASK(pA0,pA1,0);
  START(pA0,pA1);
  _Pragma("unroll") for(int r=0;r<16;++r)pA1[r]=__builtin_amdgcn_exp2f(pA1[r]);
  WAIT_BAR(0);
  DMA_K(3,s0);DMA_V(1,s1);
  ROT();
  kload8(kf,kp0+sl_cur);
  BIASLD(pB0,pB1,1); BIASSUB(pB0,pB1);
  WAIT_BAR(2);
  s16x4 vlo[8],vhi[8]; u32x4 pw0,pw1,pw2,pw3;
  #define PKW(P,B) cvtpk_s(P[B],P[B+1])
  #define PAF(k) __builtin_bit_cast(bf16x8,pw##k)
  #define VFR(i) (bf16x8){vlo[i][0],vlo[i][1],vlo[i][2],vlo[i][3],vhi[i][0],vhi[i][1],vhi[i][2],vhi[i][3]}
  #define PIN(x) asm volatile("":"+v"(x))
  #define MX3(a,b,c) __builtin_fmaxf(__builtin_fmaxf((a),(b)),(c))
  #define GAPA(MF,A0,A1,A2,A3,W0,W1,PW) do{ MF; sacc+=A0; sacc+=A1; sacc+=A2; sacc+=A3; PIN(sacc); W0; W1; PIN(PW); SBAR(); }while(0)
  #define EX(v) __builtin_amdgcn_exp2f(v)
  #define GAPB(MF,X,B,Y,GL) do{ MF; X[B]=EX(X[B]); X[B+1]=EX(X[B+1]); X[B+2]=EX(X[B+2]); X[B+3]=EX(X[B+3]); PIN(X); if(GL){ Y[B]=BS(Y[B]); Y[B+1]=BS(Y[B+1]); Y[B+2]=BS(Y[B+2]); Y[B+3]=BS(Y[B+3]); PIN(Y); } SBAR(); }while(0)
  #define VRD(i) do{ vlo[i]=vtr(vp_+(((i)>>2)*4096+((i)&3)*1024)); vhi[i]=vtr(vp_+(((i)>>2)*4096+((i)&3)*1024+512)); }while(0)
  #define KRD(G,j) do{ if(G){ kload2(kf,kp0+sl_next,j); SBAR(); } }while(0)
  #define STEP(C0,C1,P0,P1,t,GK,GV,GL) do{ SBAR(); \
    const lds_cptr vp_=vp0+sl_prev; \
    VRD(0); SBAR(); float sacc=(P0[0]+P0[1]); \
    GAPA(C0=__builtin_amdgcn_mfma_f32_32x32x16_bf16(kf[0],qr[0],C0,0,0,0), P0[2],P0[3],P0[4],P0[5],     pw0[0]=PKW(P0,0), pw0[1]=PKW(P0,2), pw0); \
    VRD(4); SBAR(); GAPA(C1=__builtin_amdgcn_mfma_f32_32x32x16_bf16(kf[1],qr[0],C1,0,0,0), P0[6],P0[7],P0[8],P0[9],     pw0[2]=PKW(P0,4), pw0[3]=PKW(P0,6), pw0); \
    VRD(1); SBAR(); GAPA(C0=__builtin_amdgcn_mfma_f32_32x32x16_bf16(kf[2],qr[1],C0,0,0,0),   P0[10],P0[11],P0[12],P0[13], pw1[0]=PKW(P0,8), pw1[1]=PKW(P0,10), pw1); \
    VRD(5); SBAR(); GAPA(C1=__builtin_amdgcn_mfma_f32_32x32x16_bf16(kf[3],qr[1],C1,0,0,0),   P0[14],P0[15],P1[0],P1[1],   pw1[2]=PKW(P0,12),pw1[3]=PKW(P0,14), pw1); \
    VRD(2); SBAR(); GAPA(C0=__builtin_amdgcn_mfma_f32_32x32x16_bf16(kf[4],qr[2],C0,0,0,0),   P1[2],P1[3],P1[4],P1[5],     pw2[0]=PKW(P1,0), pw2[1]=PKW(P1,2), pw2); \
    VRD(6); SBAR(); GAPA(C1=__builtin_amdgcn_mfma_f32_32x32x16_bf16(kf[5],qr[2],C1,0,0,0),   P1[6],P1[7],P1[8],P1[9],     pw2[2]=PKW(P1,4), pw2[3]=PKW(P1,6), pw2); \
    VRD(3); SBAR(); GAPA(C0=__builtin_amdgcn_mfma_f32_32x32x16_bf16(kf[6],qr[3],C0,0,0,0),   P1[10],P1[11],P1[12],P1[13], pw3[0]=PKW(P1,8), pw3[1]=PKW(P1,10), pw3); \
    VRD(7); SBAR(); GAPA(C1=__builtin_amdgcn_mfma_f32_32x32x16_bf16(kf[7],qr[3],C1,0,0,0),   P1[14],P1[15],0.f,0.f,       pw3[2]=PKW(P1,12),pw3[3]=PKW(P1,14), pw3); \
    l_reg+=sacc; \
    if(GL){ BIASLD(P0,P1,(t)+1); SBAR(); } \
    if(GK){DMA_K((t)+3,sl_cur);} if(GV){DMA_V((t)+1,sl_next);} \
    CMASK(C0,C1,t); \
    { float a=MX3(C0[0],C0[1],C1[0]),b=MX3(C0[2],C0[3],C1[1]); a=MX3(a,C1[2],C1[3]); \
      _Pragma("unroll") for(int r=4;r<16;r+=4){a=MX3(a,C0[r],C0[r+1]);b=MX3(b,C0[r+2],C0[r+3]);a=MX3(a,C1[r],C1[r+1]);b=MX3(b,C1[r+2],C1[r+3]);} \
      float rm=__builtin_fmaxf(a,b); { auto rr=__builtin_amdgcn_permlane32_swap(__float_as_uint(rm),__float_as_uint(rm),false,false); rm=__builtin_fmaxf(__uint_as_float(rr[0]),__uint_as_float(rr[1])); } \
      resc=false; \
      if(__builtin_expect(__any(rm>(float)THRL),0)){ const float dl=__builtin_fmaxf(rm,0.f); mhat+=dl; ctm-=dl; \
        _Pragma("unroll") for(int r=0;r<16;++r){C0[r]-=dl;C1[r]-=dl;} \
        const float f=__builtin_amdgcn_exp2f(-dl); l_reg*=f; if(hi==0)wsf[r32]=f; resc=true; } } \
    SBAR(); \
    GAPB(o[0]=__builtin_amdgcn_mfma_f32_32x32x16_bf16(PAF(0),VFR(0),o[0],0,0,0), C0,0,P0,GL); \
    GAPB(o[1]=__builtin_amdgcn_mfma_f32_32x32x16_bf16(PAF(0),VFR(4),o[1],0,0,0), C0,4,P0,GL); \
    KRD(GL,0); GAPB(o[0]=__builtin_amdgcn_mfma_f32_32x32x16_bf16(PAF(1),VFR(1),o[0],0,0,0), C0,8,P0,GL); \
    KRD(GL,1); GAPB(o[1]=__builtin_amdgcn_mfma_f32_32x32x16_bf16(PAF(1),VFR(5),o[1],0,0,0), C0,12,P0,GL); \
    KRD(GL,2); GAPB(o[0]=__builtin_amdgcn_mfma_f32_32x32x16_bf16(PAF(2),VFR(2),o[0],0,0,0), C1,0,P1,GL); \
    KRD(GL,3); GAPB(o[1]=__builtin_amdgcn_mfma_f32_32x32x16_bf16(PAF(2),VFR(6),o[1],0,0,0), C1,4,P1,GL); \
    GAPB(o[0]=__builtin_amdgcn_mfma_f32_32x32x16_bf16(PAF(3),VFR(3),o[0],0,0,0), C1,8,P1,GL); \
    GAPB(o[1]=__builtin_amdgcn_mfma_f32_32x32x16_bf16(PAF(3),VFR(7),o[1],0,0,0), C1,12,P1,GL); \
    }while(0)
  int t=1; unsigned tk=0xffffffffu; int jnv=0;
  #undef CMASK
  #define CMASK(P0,P1,t) do{}while(0)
  for(;t+5<NT;t+=2){
    STEP(pB0,pB1,pA0,pA1,t,true,true,true);     WAIT_BAR(2); RESC(); ROT();
    STEP(pA0,pA1,pB0,pB1,t+1,true,true,true);   WAIT_BAR(2); RESC(); ROT();
  }
  #undef CMASK
  #define CMASK(P0,P1,t) do{int jb_=(t)-(NT-4); if(WIN||jb_>=0)cmask<WIN>(P0,P1,jb_,qrel,hi,q0);}while(0)
  #define ENDW(tt) do{ if((tt)+3<NT){WAIT_BAR(2);} else if((tt)+2<NT){WAIT_BAR(1);} else {WAIT_BAR(0);} }while(0)
  for(;t+1<NT;t+=2){
    STEP(pB0,pB1,pA0,pA1,t,(t+3<NT),(t+1<NT),(t+1<NT));       ENDW(t);   RESC(); ROT();
    if(!WIN&&t+3==NT){ tk=(unsigned)__builtin_amdgcn_readfirstlane((int)*qslot); if(tk<2048u)jnv=j0tab[(tk&127u)*16u+(15u-(tk>>7))]; }
    STEP(pA0,pA1,pB0,pB1,t+1,(t+4<NT),(t+2<NT),(t+2<NT));     ENDW(t+1); RESC(); ROT();
  }
  const int s0n=sl_next; bool hn; int nb_,nqb_,nqc,nkc,nvc,nj0;
  if(WIN){hn=nx.has!=0;nb_=nx.b;nqb_=nx.qb;nqc=nx.qcol;nkc=nx.kcol;nvc=nx.vcol;nj0=2*nx.qb-2;}
  else{hn=tk<2048u;const int nbh=(int)(tk&127u),nhb=nbh&7;nb_=nbh>>3;nqb_=15-(int)(tk>>7);nqc=768+nhb*64;nkc=1280+nhb*64;nvc=1792+nhb*64;nj0=__builtin_amdgcn_readfirstlane(jnv);}
  if(hn){ const bf16*kn_=QKV+((long)nb_*SEQ+(long)nj0*KVBLK)*DM+nkc+(long)lane*DM+wid*8; const bf16*vn_=QKV+((long)nb_*SEQ+(long)nj0*KVBLK)*DM+nvc+(long)(16*(wid&3)+(lane>>2))*DM+(wid>>2)*32+(lane&3)*8;
    const int sb_=NEXTS(s0n),sc_=NEXTS(sb_);
    glds16(kn_,(unsigned)__builtin_amdgcn_readfirstlane(kdst+s0n)); glds16(vn_,(unsigned)__builtin_amdgcn_readfirstlane(vdst+s0n));
    glds16(kn_+(long)KVBLK*DM,(unsigned)__builtin_amdgcn_readfirstlane(kdst+sb_)); glds16(kn_+2L*KVBLK*DM,(unsigned)__builtin_amdgcn_readfirstlane(kdst+sc_)); }
  o_s0=s0n; o_tk=tk; o_j0=nj0;
  STEP(pB0,pB1,pA0,pA1,NT-1,false,false,false); RESC();
  { float sacc=pB0[0]+pB0[1]; _Pragma("unroll") for(int r=2;r<16;++r)sacc+=pB0[r]; _Pragma("unroll") for(int r=0;r<16;++r)sacc+=pB1[r]; l_reg+=sacc;
    pw0=(u32x4){PKW(pB0,0),PKW(pB0,2),PKW(pB0,4),PKW(pB0,6)};pw1=(u32x4){PKW(pB0,8),PKW(pB0,10),PKW(pB0,12),PKW(pB0,14)};pw2=(u32x4){PKW(pB1,0),PKW(pB1,2),PKW(pB1,4),PKW(pB1,6)};pw3=(u32x4){PKW(pB1,8),PKW(pB1,10),PKW(pB1,12),PKW(pB1,14)};
    SBAR(); pv(o,vb0+sl_cur,PAF(0),PAF(1),PAF(2),PAF(3)); }
  if(!WIN&&hn){ const bf16*qn_=QKV+((long)nb_*SEQ+(long)nqb_*(WIN?128:QB)+wrow)*DM+nqc+hs*D;
    #pragma unroll
    for(int d0=0;d0<4;++d0)qr[d0]=*reinterpret_cast<const bf16x8*>(&qn_[(long)r32*DM+d0*16+hi*8]); }
  float cvn[8]; float ctmn=0.f; int nkn=0;
  if(!WIN&&hn){ const float*cn=call+(size_t)(tk&127u)*SEQ; nkn=((nqb_*QB+QB)/KVBLK-nj0)*KVBLK;
    #pragma unroll
    for(int i=0;i<8;++i){const int k=tid+i*NW*64; cvn[i]=cn[nj0*KVBLK+(k<nkn?k:0)];}
    ctmn=cn[nqb_*QB+qrel]; }
  #undef PKW
  #undef PAF
  #undef VFR
  #undef PIN
  #undef MX3
  #undef GAPA
  #undef GAPB
  #undef EX
  #undef VRD
  #undef KRD
  #undef STEP
  #undef ENDW
  {auto rr=__builtin_amdgcn_permlane32_swap(__float_as_uint(l_reg),__float_as_uint(l_reg),false,false);l_reg=__uint_as_float(rr[0])+__uint_as_float(rr[1]);}
  if(WIN)l_reg+=__builtin_amdgcn_exp2f((hs?sink2b:sink2)-mhat);
  if(hi==0)wsf[32+r32]=l_reg;asm volatile("s_waitcnt lgkmcnt(0)":::"memory");
  float rli[16];
  #pragma unroll
  for(int r=0;r<16;++r)rli[r]=__builtin_amdgcn_rcpf(wsf[32+crow(r,hi)]);
  bf16*Ow=O+(rowbase+q0+wrow)*OPITCH+ocol+hs*D;
  { bf16*stg=(bf16*)(shm+LDS_OST)+wid*2048;
    #pragma unroll
    for(int r=0;r<16;++r){const int orow=crow(r,hi);
      #pragma unroll
      for(int d0=0;d0<2;++d0)stg[orow*64+d0*32+r32]=__float2bfloat16(o[d0][r]*rli[r]);}
    asm volatile("s_waitcnt lgkmcnt(0)":::"memory");
    #pragma unroll
    for(int i=0;i<4;++i){const int row=i*8+(lane>>3),ch=lane&7; const u32x4 v=*(const u32x4*)(stg+row*64+ch*8); ATTN_STORE16(Ow+(long)row*OPITCH+ch*8,v);} }
  if(!WIN&&hn){
    #pragma unroll
    for(int i=0;i<8;++i){const int k=tid+i*NW*64; if(k<nkn)csl[k]=cvn[i];} }
  ctm_io=ctmn;
  asm volatile("s_waitcnt lgkmcnt(0)\n\ts_barrier":::"memory");
  #undef DMA_K
  #undef DMA_V
  #undef CMASK
  #undef START
  #undef RESC
  #undef BIASLD
  #undef BIASSUB
  #undef BS
  #undef ROT
  #undef NEXTS
}
constexpr int ATTN_LDS_BYTES=LDS_BYTES;
#undef SBAR
#undef WAIT_BAR
}
#define GAS __attribute__((address_space(1)))
#define LAS __attribute__((address_space(3)))
typedef unsigned short bf16;
typedef unsigned v4u __attribute__((ext_vector_type(4)));
typedef float f32x4 __attribute__((ext_vector_type(4)));
constexpr int NWAVES = 8;
constexpr int BATCH = 16, SEQ = 4096, D = 1024, FF = 4096, M = BATCH * SEQ, NIN = 2312, NINP = 2304, QKVP = 2304;
constexpr float EPS = 1e-6f, LOG2E = 1.4426950408889634f;
constexpr size_t MiB = 1u << 20;
constexpr size_t WS_ROWSS = 0  , WS_C = 1 * MiB, WS_WIN = 4 * MiB, WS_WOUT = 10 * MiB, WS_WUP = 12 * MiB, WS_WDN = 20 * MiB;
constexpr size_t WS_XN = 32 * MiB  , WS_QKV = 160 * MiB  , WS_MIX = 448 * MiB  , WS_HID = 160 * MiB  , WS_END = 672 * MiB;
constexpr int RING_BYTES = 131072, LDS_BYTES = 147456;
constexpr size_t WS_BAR = 3 * MiB;
constexpr size_t WS_QCTR = WS_BAR + 16384, CTL_ZERO_BYTES = 16384 + 256;
constexpr size_t WS_J0 = 3 * MiB + 512 * 1024;
constexpr int MISC_OFF = RING_BYTES + 320;
#define LDS_WAIT() asm volatile("s_waitcnt lgkmcnt(0)" ::: "memory")
__device__ __forceinline__ unsigned f2bf(float f) { unsigned u = __builtin_bit_cast(unsigned, f); return (u + 0x7fffu + ((u >> 16) & 1u)) >> 16; }
__device__ __forceinline__ unsigned pk2(float lo, float hi) { return f2bf(lo) | (f2bf(hi) << 16); }
__device__ __forceinline__ float bf2f(unsigned short b) { return __builtin_bit_cast(float, (unsigned)b << 16); }
__device__ __forceinline__ float wave_sum(float v) {
#pragma unroll
    for (int o = 1; o < 64; o <<= 1) v += __shfl_xor(v, o);
    return v;
}
#define XB_TMO      128
#define XB_XCNT(j)  (256  + 64 * (j))
#define XB_XSUB(j)  (1280 + 64 * (j))
#define XB_XGEN(j)  (2304 + 64 * (j))
#define XB_TOP      3328
#define XB_TOPGEN   3392
#define XCD_BAR_WORDS 3456
#define XB_SPIN_CAP (1u << 18)

__device__ __forceinline__ unsigned xb_ld(unsigned* p)              { return __hip_atomic_load(p, __ATOMIC_RELAXED, __HIP_MEMORY_SCOPE_AGENT); }
__device__ __forceinline__ unsigned xb_add(unsigned* p, unsigned v) { return __hip_atomic_fetch_add(p, v, __ATOMIC_RELAXED, __HIP_MEMORY_SCOPE_AGENT); }
__device__ __forceinline__ unsigned xb_xcc_id() { return (unsigned)__builtin_amdgcn_s_getreg((3 << 11) | 20) & 0xFu; }
#define XB_SPIN(cond, bar) do { unsigned _sp = 0; while (cond) { __builtin_amdgcn_s_sleep(1); \
    if ((++_sp & 255u) == 0u) { if (xb_ld(&(bar)[XB_TMO])) break; if (_sp > XB_SPIN_CAP) { atomicAdd(&(bar)[XB_TMO], 1u); break; } } } } while (0)

struct XcdBarrier {
    unsigned* bar; unsigned x;
    volatile LAS unsigned* st;
};

__device__ __forceinline__ XcdBarrier xcd_barrier_post(unsigned* bar, volatile LAS unsigned* st) {
    XcdBarrier b; b.bar = bar; b.x = xb_xcc_id(); b.st = st;
    if (threadIdx.x == 0) (void)xb_add(&bar[XB_XCNT(b.x)], 1u);
    return b;
}
__device__ __forceinline__ void xcd_barrier_complete(unsigned* bar, unsigned x, unsigned& nloc, unsigned& nx) {
    const unsigned G = gridDim.x * gridDim.y * gridDim.z;
    unsigned sum, cnt, mine, sp = 0u;
    for (;;) {
        sum = 0u; cnt = 0u; mine = 0u;
#pragma unroll
        for (unsigned j = 0; j < 16; ++j) { const unsigned c = xb_ld(&bar[XB_XCNT(j)]); sum += c; cnt += (c > 0u) ? 1u : 0u; mine = (j == x) ? c : mine; }
        if (sum == G) break;
        __builtin_amdgcn_s_sleep(1);
        if ((++sp & 255u) == 0u) { if (xb_ld(&bar[XB_TMO])) break; if (sp > XB_SPIN_CAP) { atomicAdd(&bar[XB_TMO], 1u); break; } }
    }
    nloc = mine > 0u ? mine : 1u; nx = cnt > 0u ? cnt : 1u;
}

__device__ __forceinline__ void xcd_barrier(const XcdBarrier& b) {
    asm volatile("s_waitcnt vmcnt(0)" ::: "memory");
    __syncthreads();
    if (threadIdx.x == 0) {
        unsigned* bar = b.bar;
        __builtin_amdgcn_s_waitcnt(0);
        unsigned nloc = b.st[0], nx = b.st[1];
        if (nloc == 0u) { xcd_barrier_complete(bar, b.x, nloc, nx); b.st[0] = nloc; b.st[1] = nx; }
        const unsigned old = xb_add(&bar[XB_XSUB(b.x)], 1u);
        const unsigned gen = old / nloc;
        if (old + 1u == (gen + 1u) * nloc) {
            __builtin_amdgcn_fence(__ATOMIC_RELEASE, "agent");
            asm volatile("s_waitcnt vmcnt(0)" ::: "memory");
            const unsigned og = xb_add(&bar[XB_TOP], 1u);
            const unsigned tg = og / nx;
            if (og + 1u == (tg + 1u) * nx) xb_add(&bar[XB_TOPGEN], 1u);
            else XB_SPIN(xb_ld(&bar[XB_TOPGEN]) == tg, bar);
            __builtin_amdgcn_fence(__ATOMIC_ACQUIRE, "agent");
            xb_add(&bar[XB_XGEN(b.x)], 1u);
            asm volatile("s_waitcnt vmcnt(0)" ::: "memory");
        } else {
            XB_SPIN(xb_ld(&bar[XB_XGEN(b.x)]) == gen, bar);
            __builtin_amdgcn_fence(__ATOMIC_ACQUIRE, "agent");
            asm volatile("s_waitcnt vmcnt(0)" ::: "memory");
        }
    }
    __syncthreads();
}

__device__ __forceinline__ void p0_transpose_item(const float* W, int K, int N, int nvalid, bf16* WT, int dest_row0, int k0, int n0, const float* kscale, LAS float* scr, int lane) {
    const int col = n0 + (lane & 31);
#pragma unroll
    for (int i = 0; i < 32; ++i) { const int kk = 2 * i + (lane >> 5); float v = col < nvalid ? W[(size_t)(k0 + kk) * N + col] : 0.f; if (kscale) v *= kscale[k0 + kk]; scr[kk * 33 + (lane & 31)] = v; }
    LDS_WAIT(); asm volatile("" ::: "memory");
    const int c = lane & 7;
#pragma unroll
    for (int j = 0; j < 4; ++j) { const int n = (lane >> 3) + 8 * j; const LAS float* s = scr + (8 * c) * 33 + n;
        v4u o; o.x = pk2(s[0 * 33], s[1 * 33]); o.y = pk2(s[2 * 33], s[3 * 33]); o.z = pk2(s[4 * 33], s[5 * 33]); o.w = pk2(s[6 * 33], s[7 * 33]);
        *(GAS v4u*)(WT + (size_t)(dest_row0 + n) * K + k0 + 8 * c) = o; }
    LDS_WAIT(); asm volatile("" ::: "memory");
}
template <int NR> __device__ __forceinline__ void rms_rows_to_bf16(const float* x, const float* g, bf16* o, int m0, int mstride, int lane, const f32x4 (&wf)[4][4][2], const float* bfg, float* carr) {
    f32x4 v[NR][4];
#pragma unroll
    for (int r = 0; r < NR; ++r) { const GAS f32x4* xr = (const GAS f32x4*)(x + (size_t)(m0 + r * mstride) * D) + lane;
#pragma unroll
        for (int j = 0; j < 4; ++j) v[r][j] = xr[64 * j]; }
    f32x4 gg[4]; { const GAS f32x4* gr = (const GAS f32x4*)g + lane;
#pragma unroll
        for (int j = 0; j < 4; ++j) gg[j] = gr[64 * j]; }
    const bool up32 = (lane & 32) != 0, up16 = (lane & 16) != 0, up8 = (lane & 8) != 0;
    const int hh = (up32 ? 4 : 0) + (up16 ? 2 : 0) + (up8 ? 1 : 0); const float bh = bfg[hh];
#pragma unroll
    for (int r = 0; r < NR; ++r) { float s = 0.f; const int m = m0 + r * mstride;
#pragma unroll
        for (int j = 0; j < 4; ++j) s += (v[r][j].x * v[r][j].x + v[r][j].y * v[r][j].y) + (v[r][j].z * v[r][j].z + v[r][j].w * v[r][j].w);
        const float rstd = rsqrtf(wave_sum(s) * (1.f / D) + EPS);
        GAS unsigned long long* o8 = (GAS unsigned long long*)(o + (size_t)m * D) + lane;
        f32x4 a0 = {0.f, 0.f, 0.f, 0.f}, a1 = {0.f, 0.f, 0.f, 0.f};
#pragma unroll
        for (int j = 0; j < 4; ++j) { const f32x4 xn = v[r][j] * rstd * gg[j];
            o8[64 * j] = (unsigned long long)pk2(xn.x, xn.y) | ((unsigned long long)pk2(xn.z, xn.w) << 32);
#pragma unroll
            for (int e = 0; e < 4; ++e) { a0 += wf[j][e][0] * xn[e]; a1 += wf[j][e][1] * xn[e]; } }
        f32x4 k4 = up32 ? a1 : a0, s4 = up32 ? a0 : a1;
#pragma unroll
        for (int e = 0; e < 4; ++e) k4[e] += __shfl_xor(s4[e], 32);
        float k2a = up16 ? k4[2] : k4[0], k2b = up16 ? k4[3] : k4[1]; const float s2a = up16 ? k4[0] : k4[2], s2b = up16 ? k4[1] : k4[3];
        k2a += __shfl_xor(s2a, 16); k2b += __shfl_xor(s2b, 16);
        float k1 = up8 ? k2b : k2a; const float s1 = up8 ? k2a : k2b;
        k1 += __shfl_xor(s1, 8); k1 += __shfl_xor(k1, 4); k1 += __shfl_xor(k1, 2); k1 += __shfl_xor(k1, 1);
        if ((lane & 7) == 0) { const float z = k1 + bh; carr[(size_t)((m >> 12) * 8 + hh) * SEQ + (m & (SEQ - 1))] = fminf(z, 0.f) - log1pf(expf(-fabsf(z))); } }
}
struct Args { const float* in[13]; float* out; unsigned char* ws; };
__device__ __forceinline__ void p0_prologue(const Args& a, unsigned char* ws, LAS unsigned char* lds, int vcu, int G, int wave, int lane) {
    LAS float* scr = (LAS float*)(lds + wave * 16384);
    const int gw = vcu * NWAVES + wave, NGW = G * NWAVES;
    const float *w_in = a.in[2], *w_out = a.in[9], *w_up = a.in[11], *w_dn = a.in[12], *g2 = a.in[10];
    bf16 *Win = (bf16*)(ws + WS_WIN), *Wout = (bf16*)(ws + WS_WOUT), *Wup = (bf16*)(ws + WS_WUP), *Wdn = (bf16*)(ws + WS_WDN);
    constexpr int I_IN = 16 * 72, I_OUT = 16 * 32, I_UP = 16 * 128, I_DN = 64 * 32, NITEMS = I_IN + I_OUT + I_UP + I_DN;
    for (int it = gw; it < NITEMS; it += NGW) {
        int r = it;
        if (r < I_IN) { const int kb = r / 72, nb = r % 72, n0 = 32 * nb;
            const int dest = ((n0 >> 8) << 8) + (((n0 & 63) >> 5) << 7) + (((n0 & 255) >> 6) << 5);
            p0_transpose_item(w_in, D, NIN, NIN, Win, dest, 64 * kb, n0, nullptr, scr, lane); continue; } r -= I_IN;
        if (r < I_OUT) { p0_transpose_item(w_out, D, D, D, Wout, 32 * (r % 32), 64 * (r / 32), 32 * (r % 32), nullptr, scr, lane); continue; } r -= I_OUT;
        if (r < I_UP) { p0_transpose_item(w_up, D, FF, FF, Wup, 32 * (r % 128), 64 * (r / 128), 32 * (r % 128), g2, scr, lane); continue; } r -= I_UP;
        p0_transpose_item(w_dn, FF, D, D, Wdn, 32 * (r % 32), 64 * (r / 32), 32 * (r % 32), nullptr, scr, lane);
    }
    const float* x = a.in[0]; const float* g1 = a.in[1]; bf16* XN = (bf16*)(ws + WS_XN);
    f32x4 wf[4][4][2];
#pragma unroll
    for (int j = 0; j < 4; ++j)
#pragma unroll
        for (int e = 0; e < 4; ++e) { const float* wp = w_in + (size_t)(4 * lane + 256 * j + e) * NIN + QKVP; wf[j][e][0] = *(const f32x4*)wp; wf[j][e][1] = *(const f32x4*)(wp + 4); }
    float* carr = (float*)(ws + WS_C);
    { int m = gw; for (; m + 3 * NGW < M; m += 4 * NGW) rms_rows_to_bf16<4>(x, g1, XN, m, NGW, lane, wf, a.in[3], carr); for (; m < M; m += NGW) rms_rows_to_bf16<1>(x, g1, XN, m, NGW, lane, wf, a.in[3], carr); }
}
__device__ __forceinline__ void scan_seq(float* seq, int* j0row, float skipthr, LAS float* scr, int tid, int wave, int lane) {
    f32x4 a = *(const f32x4*)(seq + 8 * tid), b = *(const f32x4*)(seq + 8 * tid + 4);
    a[1] += a[0]; a[2] += a[1]; a[3] += a[2]; b[0] += a[3]; b[1] += b[0]; b[2] += b[1]; b[3] += b[2];
    float tot = b[3], inc = tot;
#pragma unroll
    for (int o = 1; o < 64; o <<= 1) { const float t = __shfl_up(inc, o); if (lane >= o) inc += t; }
    if (lane == 63) scr[wave] = inc;
    __syncthreads();
    float base = inc - tot;
    for (int w = 0; w < wave; ++w) base += scr[w];
    a = (a + base) * LOG2E; b = (b + base) * LOG2E;
    *(f32x4*)(seq + 8 * tid) = a; *(f32x4*)(seq + 8 * tid + 4) = b;
    if ((tid & 7) == 7) scr[16 + (tid >> 3)] = b[3];
    if ((tid & 31) == 0) scr[96 + (tid >> 5)] = a[0];
    __syncthreads();
#pragma unroll
    for (int k = 0; k < 2; ++k) { const int qb = 2 * wave + k, NTf = 4 * qb + 4; const float cq = scr[96 + qb], ce = scr[16 + lane];
        const unsigned long long need = __ballot(lane < NTf && ce <= cq + skipthr);
        int jf = need ? (int)__ffsll((long long)need) - 1 : NTf; jf &= ~1; if (jf > NTf - 4) jf = NTf - 4;
        if (lane == 0) j0row[qb] = jf; }
    __syncthreads();
}
#define WSP(T, off) ((T*)(args.ws + (off)))
__global__ void __launch_bounds__(NWAVES * 64, 2) fwd_kernel(Args args) {
    extern __shared__ __attribute__((aligned(16))) unsigned char lds_raw[];
    cg::grid_group grid = cg::this_grid();
    LAS unsigned char* lds = (LAS unsigned char*)lds_raw;
    const int tid = threadIdx.x, lane = tid & 63, wave = __builtin_amdgcn_readfirstlane(tid >> 6);
    const int G = gridDim.x, bx = blockIdx.x, vcu = (G % 8 == 0) ? (bx % 8) * (G / 8) + bx / 8 : bx;
    constexpr bool ALIGN = true, SP2 = true;
    volatile LAS unsigned* bst = (volatile LAS unsigned*)(lds + MISC_OFF);
    if (tid == 0) { bst[0] = 0u; bst[1] = 0u; }
    unsigned* barw = WSP(unsigned, WS_BAR);
    const XcdBarrier xbar = xcd_barrier_post(barw, bst);
    if (args.ws == nullptr) grid.sync();

    p0_prologue(args, args.ws, lds, vcu, G, wave, lane);
    xcd_barrier(xbar);

    float skipthr;
    { float mq = fabsf(args.in[7][lane]), mk = fabsf(args.in[8][lane]);
#pragma unroll
      for (int o = 1; o < 64; o <<= 1) { mq = fmaxf(mq, __shfl_xor(mq, o)); mk = fmaxf(mk, __shfl_xor(mk, o)); }
      skipthr = 2.f * (8.f * mq * mk * LOG2E * 1.01f) + 50.f; }
    for (int i = bx; i < BATCH * 8; i += G) scan_seq(WSP(float, WS_C) + (size_t)i * SEQ, WSP(int, WS_J0) + i * 16, skipthr, (LAS float*)lds, tid, wave, lane);
    { pg8::Gemm g{WSP(bf16, WS_XN), WSP(bf16, WS_WIN), M, NINP, D}; pg8::StaticOrder S; S.init(M, NINP, G, bx, pg8::WGM, (M / 256 * (NINP / 256)) % G == 0 ? 1 : 0);
      pg8::EpiInProj E{WSP(bf16, WS_QKV), args.in[4], args.in[5], args.in[7], args.in[8]};
      pg8::gemm_phase<pg8::EpiInProj, pg8::StaticOrder, ALIGN, SP2>(lds, g, S, E); }
    xcd_barrier(xbar);

    float ctmc = 0.f;
    attn_body::bf16x8 qfr[4] = {};
    volatile LAS unsigned* qslot = (volatile LAS unsigned*)(lds + MISC_OFF + 64);
    { const int NU = BATCH * 2 * 2 * 32, per = (NU + G - 1) / G; int s0 = 0; bool hd = false;
      for (int i = 0; i < per; ++i) { const int u = vcu * per + i; if (u >= NU) break; const int qb = u & 31, pr = (u >> 5) & 1, kvh = (u >> 6) & 1, b = u >> 7, h0 = 4 * kvh + 2 * pr;
          const int un = u + 1; const bool hasn = (i + 1 < per) && (un < NU); const int nkvh = (un >> 6) & 1, nh0 = 4 * nkvh + 2 * ((un >> 5) & 1);
          const attn_body::AttnNext nx{hasn ? 1 : 0, un >> 7, un & 31, nh0 * 64, 512 + nkvh * 64, 640 + nkvh * 64};
          int s0n = 0, j0n = 0; unsigned tkn = 0u;
          attn_body::attn_unit<16, true>(b, qb, 2 * qb - 2, h0 * 64, 512 + kvh * 64, 640 + kvh * 64, h0 * 64, (const attn_body::bf16*)WSP(bf16, WS_QKV), (attn_body::bf16*)WSP(bf16, WS_MIX), nullptr,
                                         exp2f(-(float)(h0 + 1)) * LOG2E, args.in[6][h0] * LOG2E, args.in[6][h0 + 1] * LOG2E, s0, hd, qfr, nx, 0u, qslot, nullptr, nullptr, ctmc, s0n, tkn, j0n, (char*)lds_raw);
          s0 = s0n; hd = hasn; } }
    { const int NU = BATCH * 8 * 16; unsigned* qctr = WSP(unsigned, WS_QCTR); const int* j0tab = WSP(int, WS_J0);
      int u = bx, s0 = 0; bool hd = false;
      int j0 = u < NU ? j0tab[(u & 127) * 16 + (15 - (u >> 7))] : 0;
      while (u < NU) {
          unsigned nxt = 0u;
          if (tid == 0) nxt = (unsigned)G + __hip_atomic_fetch_add(qctr, 1u, __ATOMIC_RELAXED, __HIP_MEMORY_SCOPE_AGENT);
          const int bh = u & 127, qb = 15 - (u >> 7), hb = bh & 7;
          int s0n = 0, j0n = 0; unsigned tkn = 0xffffffffu;
          attn_body::attn_unit<16, false>(bh >> 3, qb, __builtin_amdgcn_readfirstlane(j0), 768 + hb * 64, 1280 + hb * 64, 1792 + hb * 64, 512 + hb * 64, (const attn_body::bf16*)WSP(bf16, WS_QKV), (attn_body::bf16*)WSP(bf16, WS_MIX),
                                          WSP(float, WS_C) + (size_t)bh * SEQ, 0.f, 0.f, 0.f, s0, hd, qfr, attn_body::AttnNext{0, 0, 0, 0, 0, 0}, nxt, qslot, j0tab, WSP(float, WS_C), ctmc, s0n, tkn, j0n, (char*)lds_raw);
          u = tkn < (unsigned)NU ? (int)tkn : NU; j0 = j0n; s0 = s0n; hd = u < NU;
      } }
    xcd_barrier(xbar);

    { pg8::Gemm g{WSP(bf16, WS_MIX), WSP(bf16, WS_WOUT), M, D, D}; pg8::StaticOrder S; S.init(M, D, G, bx);
      pg8::EpiOutProj E{args.in[0], WSP(bf16, WS_XN), WSP(float, WS_ROWSS), (PG8_LAS float*)(lds + RING_BYTES + 1024)};
      pg8::gemm_phase<pg8::EpiOutProj, pg8::StaticOrder, ALIGN, SP2>(lds, g, S, E); }
    xcd_barrier(xbar);

    { pg8::Gemm g{WSP(bf16, WS_XN), WSP(bf16, WS_WUP), M, FF, D}; pg8::StaticOrder S; S.init(M, FF, G, bx, pg8::WGM, (M / 256 * (FF / 256)) % G == 0 ? 1 : 0);
      pg8::EpiUp E{WSP(bf16, WS_HID), WSP(float, WS_ROWSS)};
      pg8::gemm_phase<pg8::EpiUp, pg8::StaticOrder, ALIGN, SP2>(lds, g, S, E); }
    xcd_barrier(xbar);

    { pg8::Gemm g{WSP(bf16, WS_HID), WSP(bf16, WS_WDN), M, D, FF}; pg8::StaticOrder S; S.init(M, D, G, bx);
      pg8::EpiDown E{WSP(bf16, WS_XN), args.out};
      pg8::gemm_phase<pg8::EpiDown, pg8::StaticOrder, ALIGN, SP2>(lds, g, S, E); }
}
#undef WSP
extern "C" void kernel_launch(void* const* d_in, const int* in_sizes, int n_in, void* d_out, int out_size, void* d_ws, size_t ws_size, hipStream_t stream) {
    static int grid = 0;
    if (grid == 0) {
        if (n_in != 13 || in_sizes[0] != M * D || out_size != M * D || ws_size < WS_END) { fprintf(stderr, "kernel_launch: unexpected shapes (n_in %d, in0 %d, out %d, ws %zu)\n", n_in, n_in > 0 ? in_sizes[0] : -1, out_size, ws_size); grid = -1; return; }
        int dev = 0, cus = 0, per_cu = 0;
        if (hipGetDevice(&dev) != hipSuccess || hipDeviceGetAttribute(&cus, hipDeviceAttributeMultiprocessorCount, dev) != hipSuccess) { grid = -1; return; }
        if (hipFuncSetAttribute((const void*)fwd_kernel, hipFuncAttributeMaxDynamicSharedMemorySize, LDS_BYTES) != hipSuccess) { fprintf(stderr, "kernel_launch: hipFuncSetAttribute failed\n"); grid = -1; return; }
        if (hipOccupancyMaxActiveBlocksPerMultiprocessor(&per_cu, (const void*)fwd_kernel, NWAVES * 64, LDS_BYTES) != hipSuccess || per_cu < 1) { fprintf(stderr, "kernel_launch: occupancy query gives %d\n", per_cu); per_cu = 1; }
        (void)hipGetLastError();
        grid = cus * per_cu;
    }
    if (grid < 0) return;
    if (hipMemsetAsync((char*)d_ws + WS_BAR, 0, CTL_ZERO_BYTES, stream) != hipSuccess) { fprintf(stderr, "kernel_launch: hipMemsetAsync of the control words failed; nothing launched\n"); return; }
    Args a{};
    for (int i = 0; i < 13; ++i) a.in[i] = (const float*)d_in[i];
    a.out = (float*)d_out; a.ws = (unsigned char*)d_ws;
    void* params[] = {&a};
    hipError_t e = hipLaunchCooperativeKernel((const void*)fwd_kernel, dim3(grid), dim3(NWAVES * 64), params, LDS_BYTES, stream);
    if (e != hipSuccess) fprintf(stderr, "kernel_launch: cooperative launch failed: %s (grid %d)\n", hipGetErrorString(e), grid);
}
```

```cpp
#include <hip/hip_runtime.h>
#include <hip/hip_cooperative_groups.h>
#include <hip/hip_bf16.h>
#include <cstdio>
#include <cstdint>
#include <cmath>
namespace cg = cooperative_groups;
#ifndef PG8_WGM
#define PG8_WGM 8
#endif
namespace pg8 {
#define PG8_LAS __attribute__((address_space(3)))
typedef unsigned short bf16_t;
typedef short bf16x8 __attribute__((ext_vector_type(8)));
typedef float f32x4 __attribute__((ext_vector_type(4)));
typedef unsigned u32x4 __attribute__((ext_vector_type(4)));
constexpr int BM = 256, BK = 64, HALF = 128, HTB = HALF * BK * 2  , STAGE_BYTES = 8 * HTB, NXCD = 8, WGM = PG8_WGM;

__host__ __device__ __forceinline__ int lds_byte(int r, int c) { const int st = (r >> 4) * 2 + (c >> 5), rr = r & 15, cc = c & 31, ob = rr * 64 + cc * 2; return st * 1024 + (ob ^ (((ob >> 9) & 1) << 5)); }
__host__ __device__ __forceinline__ void stage_rc(int b, int& R, int& C) { const int st = b / 1024, sb = b % 1024, swz = sb ^ (((sb >> 9) & 1) << 5); R = (st >> 1) * 16 + swz / 64; C = (st & 1) * 32 + (swz % 64) / 2; }
__host__ __device__ __forceinline__ int perm32(int rho) { const int n = rho >> 4, i = rho & 15; return 8 * (i >> 2) + 4 * n + (i & 3); }

struct Unit { int pm, pn; };
struct Gemm { const bf16_t* A; const bf16_t* Bt; int M, N, K; };

struct StaticOrder {
    int nM, nN, nwg, G, c, wgm, rev;
    __host__ __device__ void init(int M, int N, int G_, int c_, int wgm_ = WGM, int rev_ = 0) { nM = M / BM; nN = N / BM; nwg = nM * nN; G = G_; c = c_; wgm = wgm_; rev = rev_; }
    __host__ __device__ bool next(int i, Unit& u) const {
        const int nr = (nwg + G - 1) / G; if (i >= nr) return false;
        const long L = (long)(rev ? nr - 1 - i : i) * G + c; if (L >= nwg) return false;
        int wgid = (int)L; { const int q = nwg / NXCD, r = nwg % NXCD, xcd = wgid % NXCD, off = wgid / NXCD; wgid = (xcd < r ? xcd * (q + 1) : r * (q + 1) + (xcd - r) * q) + off; }
        const int nig = wgm * nN, gid = wgid / nig, fm = gid * wgm, gsz = (nM - fm) < wgm ? (nM - fm) : wgm;
        u.pm = fm + ((wgid % nig) % gsz); u.pn = (wgid % nig) / gsz; return true;
    }
    __device__ __forceinline__ void a_ready(const Unit&) const {}
    __device__ __forceinline__ void done(const Unit&) const {}
};

__device__ __forceinline__ unsigned cvt_pk_bf16(float lo, float hi) { unsigned r; asm volatile("v_cvt_pk_bf16_f32 %0, %1, %2" : "=v"(r) : "v"(lo), "v"(hi)); return r; }
typedef float f32x2 __attribute__((ext_vector_type(2)));
#ifndef EPI_TOUCH_X
#define EPI_TOUCH_X false
#endif
#ifndef EPI_TOUCH_H
#define EPI_TOUCH_H false
#endif
#ifndef EPI_NT
#define EPI_NT 0
#endif
#if EPI_NT
#define NT_STORE16(p, v) __builtin_nontemporal_store((v), (u32x4*)(p))
#define NT_STOREF4(p, v) __builtin_nontemporal_store((v), (f32x4*)(p))
#else
#define NT_STORE16(p, v) (*(u32x4*)(p) = (v))
#define NT_STOREF4(p, v) (*(f32x4*)(p) = (v))
#endif
constexpr float EPI_C2 = 0.125f * 1.4426950408889634f;
constexpr int QKV_PITCH = 2304;
struct EpiInProj {
    static constexpr bool PERM = true, AFTER_DRAIN = false, TOUCH = false; static constexpr int REPS = 1;
    bf16_t* QKV; const float *qna, *kna, *qnb, *knb;
    __device__ __forceinline__ void operator()(const f32x4 (&acc)[2][2][4][2], const Unit& u, int wr, int wc, int fr, int fq) const {
        const int hs = u.pn * 4 + wc;
        const int row0 = u.pm * BM + wr * 64 + fr;
        const float* g = nullptr; float sc = 1.f;
        if (hs < 8) { g = qna; sc = EPI_C2; } else if (hs < 10) { g = kna; } else if (hs < 12) { } else if (hs < 20) { g = qnb; sc = EPI_C2; } else if (hs < 28) { g = knb; }
        f32x4 gv[2][2];
#pragma unroll
        for (int bj = 0; bj < 2; ++bj)
#pragma unroll
            for (int n = 0; n < 2; ++n) gv[bj][n] = g ? *(const f32x4*)(g + 32 * bj + 8 * fq + 4 * n) * sc : (f32x4){1.f, 1.f, 1.f, 1.f};
        bf16_t* base = QKV + hs * 64 + 8 * fq;
#pragma unroll
        for (int ai = 0; ai < 2; ++ai)
#pragma unroll
            for (int m = 0; m < 4; ++m) { const int row = row0 + ai * HALF + m * 16;
                float rinv = 1.f;
                if (g) { float ss = 0.f;
#pragma unroll
                    for (int bj = 0; bj < 2; ++bj)
#pragma unroll
                        for (int n = 0; n < 2; ++n) { const f32x4 v = acc[ai][bj][m][n]; ss += (v[0] * v[0] + v[1] * v[1]) + (v[2] * v[2] + v[3] * v[3]); }
                    ss += __shfl_xor(ss, 16); ss += __shfl_xor(ss, 32);
                    rinv = rsqrtf(ss * (1.f / 64.f) + 1e-6f); }
#pragma unroll
                for (int bj = 0; bj < 2; ++bj) { const f32x4 v0 = acc[ai][bj][m][0] * rinv * gv[bj][0], v1 = acc[ai][bj][m][1] * rinv * gv[bj][1];
                    u32x4 w; w.x = cvt_pk_bf16(v0[0], v0[1]); w.y = cvt_pk_bf16(v0[2], v0[3]); w.z = cvt_pk_bf16(v1[0], v1[1]); w.w = cvt_pk_bf16(v1[2], v1[3]);
                    *(u32x4*)(base + (size_t)row * QKV_PITCH + 32 * bj) = w; } }
    }
};
struct EpiOutProj {
    static constexpr bool PERM = true, AFTER_DRAIN = false, TOUCH = EPI_TOUCH_X; static constexpr int REPS = 1;
    const float* x; bf16_t* hb; float* part; PG8_LAS float* red;
    __device__ __forceinline__ void touch(const Unit& u, int tid, unsigned& reg) const {
        const char* p = (const char*)(x + (size_t)(u.pm * BM + (tid & 255)) * 1024 + u.pn * BM) + (tid >> 8) * 512;
#pragma unroll
        for (int l = 0; l < 4; ++l) asm volatile("global_load_dword %0, %1, off offset:%c2" : "+v"(reg) : "v"(p), "i"(l * 128) : "memory");
    }
    __device__ __forceinline__ void operator()(const f32x4 (&acc)[2][2][4][2], const Unit& u, int wr, int wc, int fr, int fq) const {
        const int row0 = u.pm * BM + wr * 64 + fr, col0 = u.pn * BM + wc * 32 + 8 * fq;
#pragma unroll
        for (int ai = 0; ai < 2; ++ai) {
            f32x4 xr[4][2][2];
#pragma unroll
            for (int m = 0; m < 4; ++m) { const size_t off = (size_t)(row0 + ai * HALF + m * 16) * 1024 + col0;
#pragma unroll
                for (int bj = 0; bj < 2; ++bj) { xr[m][bj][0] = *(const f32x4*)(x + off + bj * HALF); xr[m][bj][1] = *(const f32x4*)(x + off + bj * HALF + 4); } }
#pragma unroll
            for (int m = 0; m < 4; ++m) { const int row = row0 + ai * HALF + m * 16; const size_t off = (size_t)row * 1024 + col0; float ss = 0.f;
#pragma unroll
                for (int bj = 0; bj < 2; ++bj) { const f32x4 v0 = acc[ai][bj][m][0] + xr[m][bj][0], v1 = acc[ai][bj][m][1] + xr[m][bj][1];
                    u32x4 w; w.x = cvt_pk_bf16(v0[0], v0[1]); w.y = cvt_pk_bf16(v0[2], v0[3]); w.z = cvt_pk_bf16(v1[0], v1[1]); w.w = cvt_pk_bf16(v1[2], v1[3]);
                    *(u32x4*)(hb + off + bj * HALF) = w;
                    ss += (v0[0] * v0[0] + v0[1] * v0[1]) + (v0[2] * v0[2] + v0[3] * v0[3]) + (v1[0] * v1[0] + v1[1] * v1[1]) + (v1[2] * v1[2] + v1[3] * v1[3]); }
                ss += __shfl_xor(ss, 16); ss += __shfl_xor(ss, 32);
                if (fq == 0) red[(ai * HALF + wr * 64 + m * 16 + fr) * 4 + wc] = ss; } }
        asm volatile("s_waitcnt lgkmcnt(0)" ::: "memory"); __builtin_amdgcn_s_barrier(); asm volatile("" ::: "memory");
        const int t = (wr * 4 + wc) * 64 + fq * 16 + fr;
        if (t < BM) { const f32x4 p = *(const PG8_LAS f32x4*)(red + t * 4); part[(size_t)(u.pm * BM + t) * 4 + u.pn] = (p[0] + p[1]) + (p[2] + p[3]); }
    }
};
struct EpiUp {
    static constexpr bool PERM = true, AFTER_DRAIN = false, TOUCH = false;
#ifdef REP_EPI_UP
    static constexpr int REPS = REP_EPI_UP;
#else
    static constexpr int REPS = 1;
#endif
    bf16_t* hid; const float* rowss;
    __device__ __forceinline__ void operator()(const f32x4 (&acc)[2][2][4][2], const Unit& u, int wr, int wc, int fr, int fq) const {
        const int row0 = u.pm * BM + wr * 64 + fr, col0 = u.pn * BM + wc * 32 + 8 * fq;
        float rs[2][4];
#pragma unroll
        for (int ai = 0; ai < 2; ++ai)
#pragma unroll
            for (int m = 0; m < 4; ++m) { const f32x4 pp = *(const f32x4*)(rowss + (size_t)(row0 + ai * HALF + m * 16) * 4); rs[ai][m] = (pp[0] + pp[1]) + (pp[2] + pp[3]); }
#pragma unroll
        for (int ai = 0; ai < 2; ++ai)
#pragma unroll
            for (int m = 0; m < 4; ++m) { const int row = row0 + ai * HALF + m * 16; const float r = rsqrtf(rs[ai][m] * (1.f / 1024.f) + 1e-6f);
                bf16_t* rowp = hid + (size_t)row * 4096 + col0;
#pragma unroll
                for (int bj = 0; bj < 2; ++bj) { f32x4 v0 = acc[ai][bj][m][0] * r, v1 = acc[ai][bj][m][1] * r;
#pragma unroll
                    for (int j = 0; j < 4; ++j) { v0[j] = fmaxf(v0[j], 0.f); v1[j] = fmaxf(v1[j], 0.f); }
                    v0 = v0 * v0; v1 = v1 * v1;
                    u32x4 w; w.x = cvt_pk_bf16(v0[0], v0[1]); w.y = cvt_pk_bf16(v0[2], v0[3]); w.z = cvt_pk_bf16(v1[0], v1[1]); w.w = cvt_pk_bf16(v1[2], v1[3]);
                    NT_STORE16(rowp + bj * HALF, w); } }
    }
};
struct EpiDown {
    static constexpr bool PERM = true, AFTER_DRAIN = false, TOUCH = EPI_TOUCH_H; static constexpr int REPS = 1;
    const bf16_t* hb; float* out;
    __device__ __forceinline__ void touch(const Unit& u, int tid, unsigned& reg) const {
        const char* p = (const char*)(hb + (size_t)(u.pm * BM + (tid & 255)) * 1024 + u.pn * BM) + (tid >> 8) * 256;
#pragma unroll
        for (int l = 0; l < 2; ++l) asm volatile("global_load_dword %0, %1, off offset:%c2" : "+v"(reg) : "v"(p), "i"(l * 128) : "memory");
    }
    __device__ __forceinline__ void operator()(const f32x4 (&acc)[2][2][4][2], const Unit& u, int wr, int wc, int fr, int fq) const {
        const int row0 = u.pm * BM + wr * 64 + fr, col0 = u.pn * BM + wc * 32 + 8 * fq;
        u32x4 hr[2][4][2];
#pragma unroll
        for (int ai = 0; ai < 2; ++ai)
#pragma unroll
            for (int m = 0; m < 4; ++m)
#pragma unroll
                for (int bj = 0; bj < 2; ++bj) hr[ai][m][bj] = *(const u32x4*)(hb + (size_t)(row0 + ai * HALF + m * 16) * 1024 + col0 + bj * HALF);
#pragma unroll
        for (int ai = 0; ai < 2; ++ai)
#pragma unroll
            for (int m = 0; m < 4; ++m) { float* rowp = out + (size_t)(row0 + ai * HALF + m * 16) * 1024 + col0;
#pragma unroll
                for (int bj = 0; bj < 2; ++bj) { const u32x4 h = hr[ai][m][bj];
                    const f32x4 a = {__builtin_bit_cast(float, h.x << 16), __builtin_bit_cast(float, h.x & 0xffff0000u), __builtin_bit_cast(float, h.y << 16), __builtin_bit_cast(float, h.y & 0xffff0000u)};
                    const f32x4 b = {__builtin_bit_cast(float, h.z << 16), __builtin_bit_cast(float, h.z & 0xffff0000u), __builtin_bit_cast(float, h.w << 16), __builtin_bit_cast(float, h.w & 0xffff0000u)};
                    NT_STOREF4(rowp + bj * HALF, a + acc[ai][bj][m][0]); NT_STOREF4(rowp + bj * HALF + 4, b + acc[ai][bj][m][1]); } }
    }
};
template <class Epi, class Sched, bool ALIGN_EPI = false, bool SP2 = false, int NARROW_PN = -1, bool PF = false>
__device__ __forceinline__ void gemm_phase(PG8_LAS unsigned char* lds, const Gemm g, const Sched& S, const Epi& E) {
    int tid_l = threadIdx.x; asm volatile("" : "+v"(tid_l));
    const int tid = tid_l, wid = __builtin_amdgcn_readfirstlane(tid >> 6), lane = tid & 63, wr = wid >> 2, wc = wid & 3, fr = lane & 15, fq = lane >> 4;
    const int K = g.K, nt = K / BK;
    unsigned voffA[2], voffB[2];
#pragma unroll
    for (int i = 0; i < 2; ++i) { int R, C; stage_rc(tid * 16 + i * 8192, R, C); const int Rb = Epi::PERM ? ((R & ~31) + perm32(R & 31)) : R;
        voffA[i] = (unsigned)(R * K + C) * 2u; voffB[i] = (unsigned)(Rb * K + C) * 2u; }
    const size_t kstep = (size_t)(BK * 2);
    const size_t hstep = (size_t)HALF * K * 2;
    const size_t tstep = 2 * hstep;
    unsigned pfreg = 0u; const unsigned pfoff = (unsigned)(tid & 255) * (unsigned)K * 2u; const bool pfB = wid >= 4;
    const unsigned ldsw = (unsigned)wid * 1024u;
    const int aoff = lds_byte(wr * 64 + fr, fq * 8), boff = lds_byte(wc * 32 + fr, fq * 8);
#define PG8_SA(b, h) (((b) * 2 + (h)) * HTB)
#define PG8_SB(b, h) ((4 + (b) * 2 + (h)) * HTB)
#define PG8_STAGE(bufoff, gbase, voff) do { _Pragma("unroll") for (int _i = 0; _i < 2; ++_i) \
        __builtin_amdgcn_global_load_lds((const unsigned*)((const char*)(gbase) + (voff)[_i]), (PG8_LAS unsigned*)(lds + (bufoff) + ldsw + _i * 8192), 16, 0, 0); } while (0)
#define PG8_LDA(dst, b, h) do { _Pragma("unroll") for (int m = 0; m < 4; ++m) _Pragma("unroll") for (int k = 0; k < 2; ++k) dst[m][k] = *(const PG8_LAS bf16x8*)(lds + PG8_SA(b, h) + aoff + m * 2048 + k * 1024); } while (0)
#define PG8_LDB(dst, b, h) do { _Pragma("unroll") for (int n = 0; n < 2; ++n) _Pragma("unroll") for (int k = 0; k < 2; ++k) dst[n][k] = *(const PG8_LAS bf16x8*)(lds + PG8_SB(b, h) + boff + n * 2048 + k * 1024); } while (0)
#define PG8_MMA(ai, bj, At, Bt) do { __builtin_amdgcn_s_setprio(1); _Pragma("unroll") for (int m = 0; m < 4; ++m) _Pragma("unroll") for (int n = 0; n < 2; ++n) _Pragma("unroll") for (int k = 0; k < 2; ++k) \
        acc[ai][bj][m][n] = __builtin_amdgcn_mfma_f32_16x16x32_bf16(Bt[n][k], At[m][k], acc[ai][bj][m][n], 0, 0, 0); __builtin_amdgcn_s_setprio(0); } while (0)
#define PG8_WAIT_V(n) asm volatile("s_waitcnt vmcnt(" #n ")" ::: "memory")
#define PG8_WAIT_VL() do { if constexpr (PF) PG8_WAIT_V(9); else PG8_WAIT_V(8); } while (0)
#define PG8_PF(kt) do { if constexpr (PF) { const int k_ = (kt); const char* base_ = k_ < nt ? (pfB ? cB : cA) + (size_t)k_ * kstep : (pfB ? nB : nA) + (size_t)(k_ - nt) * kstep; \
        asm volatile("global_load_dword %0, %1, off" : "+v"(pfreg) : "v"(base_ + pfoff) : "memory"); } } while (0)
#define PG8_WAIT_L(n) asm volatile("s_waitcnt lgkmcnt(" #n ")" ::: "memory")
#define PG8_BAR __builtin_amdgcn_s_barrier()
#define PG8_SCHED __builtin_amdgcn_sched_barrier(0)
    Unit cur, nxt; int ui = 0;
    if (!S.next(0, cur)) return;
    f32x4 acc[2][2][4][2];
#pragma unroll
    for (int a = 0; a < 2; ++a)
#pragma unroll
        for (int b = 0; b < 2; ++b)
#pragma unroll
            for (int m = 0; m < 4; ++m)
#pragma unroll
                for (int n = 0; n < 2; ++n) acc[a][b][m][n] = (f32x4){0.f, 0.f, 0.f, 0.f};
    bf16x8 At[4][2], B0[2][2], B1[2][2];
    const char* cA = (const char*)g.A + (size_t)cur.pm * tstep; const char* cB = (const char*)g.Bt + (size_t)cur.pn * tstep;
    S.a_ready(cur);
    if constexpr (SP2) {
        PG8_STAGE(PG8_SB(0, 0), cB, voffB); PG8_STAGE(PG8_SB(0, 1), cB + hstep, voffB); PG8_STAGE(PG8_SA(0, 0), cA, voffA); PG8_STAGE(PG8_SA(0, 1), cA + hstep, voffA);
        if (wr == 1) PG8_BAR;
        PG8_WAIT_V(2); PG8_BAR;
        PG8_STAGE(PG8_SB(1, 0), cB + kstep, voffB); PG8_STAGE(PG8_SA(1, 0), cA + kstep, voffA); PG8_STAGE(PG8_SB(1, 1), cB + hstep + kstep, voffB);
        PG8_WAIT_V(6); PG8_BAR;
    } else {
        PG8_STAGE(PG8_SB(0, 0), cB, voffB); PG8_STAGE(PG8_SA(0, 0), cA, voffA); PG8_STAGE(PG8_SB(0, 1), cB + hstep, voffB); PG8_STAGE(PG8_SA(0, 1), cA + hstep, voffA);
        if (wr == 1) PG8_BAR;
        PG8_WAIT_V(4); PG8_BAR;
        PG8_STAGE(PG8_SB(1, 0), cB + kstep, voffB); PG8_STAGE(PG8_SA(1, 0), cA + kstep, voffA); PG8_STAGE(PG8_SB(1, 1), cB + hstep + kstep, voffB);
        PG8_WAIT_V(6); PG8_BAR;
    }
    for (;;) {
        const bool has_next = S.next(ui + 1, nxt);
        if constexpr (Epi::TOUCH) E.touch(cur, tid, pfreg);
        const char* nA = has_next ? (const char*)g.A + (size_t)nxt.pm * tstep : cA; const char* nB = has_next ? (const char*)g.Bt + (size_t)nxt.pn * tstep : cB;
        const bool narrow = NARROW_PN >= 0 && cur.pn == NARROW_PN;
        for (int t = 0; t < nt; t += 2) {
            const bool last = (t == nt - 2);
            const char* a1 = cA + (size_t)(t + 1) * kstep;
            const char* a2 = last ? nA : cA + (size_t)(t + 2) * kstep; const char* b2 = last ? nB : cB + (size_t)(t + 2) * kstep;
            const char* a3 = a2 + kstep; const char* b3 = b2 + kstep;
            if (last && has_next) S.a_ready(nxt);
            if constexpr (SP2) {
            PG8_LDB(B0, 0, 0); PG8_LDB(B1, 0, 1); PG8_SCHED; PG8_LDA(At, 0, 0); PG8_STAGE(PG8_SA(1, 1), a1 + hstep, voffA); PG8_PF(t + 4);
            PG8_WAIT_VL(); PG8_WAIT_L(0); PG8_BAR; PG8_MMA(0, 0, At, B0); if (!narrow) PG8_MMA(0, 1, At, B1); PG8_BAR; PG8_SCHED;
            PG8_LDA(At, 0, 1); PG8_STAGE(PG8_SB(0, 0), b2, voffB); PG8_STAGE(PG8_SB(0, 1), b2 + hstep, voffB); PG8_STAGE(PG8_SA(0, 0), a2, voffA);
            PG8_WAIT_VL(); PG8_WAIT_L(0); PG8_BAR; PG8_MMA(1, 0, At, B0); if (!narrow) PG8_MMA(1, 1, At, B1); PG8_BAR; PG8_SCHED;
            PG8_LDB(B0, 1, 0); PG8_LDB(B1, 1, 1); PG8_SCHED; PG8_LDA(At, 1, 0); PG8_STAGE(PG8_SA(0, 1), a2 + hstep, voffA); PG8_PF(t + 5);
            PG8_WAIT_VL(); PG8_WAIT_L(0); PG8_BAR; PG8_MMA(0, 0, At, B0); if (!narrow) PG8_MMA(0, 1, At, B1); PG8_BAR; PG8_SCHED;
            PG8_LDA(At, 1, 1); PG8_STAGE(PG8_SB(1, 0), b3, voffB); PG8_STAGE(PG8_SB(1, 1), b3 + hstep, voffB); PG8_STAGE(PG8_SA(1, 0), a3, voffA);
            PG8_WAIT_VL(); PG8_WAIT_L(0); PG8_BAR; PG8_MMA(1, 0, At, B0); if (!narrow) PG8_MMA(1, 1, At, B1); PG8_BAR; PG8_SCHED;
            } else {
            PG8_LDB(B0, 0, 0); PG8_SCHED; PG8_LDA(At, 0, 0); PG8_STAGE(PG8_SA(1, 1), a1 + hstep, voffA);
            PG8_WAIT_L(8); PG8_BAR; PG8_WAIT_L(0); PG8_MMA(0, 0, At, B0); PG8_BAR; PG8_SCHED;
            PG8_LDB(B1, 0, 1); PG8_STAGE(PG8_SB(0, 0), b2, voffB);
            PG8_BAR; PG8_WAIT_L(0); PG8_MMA(0, 1, At, B1); PG8_BAR;
            PG8_LDA(At, 0, 1); PG8_STAGE(PG8_SA(0, 0), a2, voffA);
            PG8_BAR; PG8_WAIT_L(0); PG8_MMA(1, 0, At, B0); PG8_BAR; PG8_SCHED;
            PG8_STAGE(PG8_SB(0, 1), b2 + hstep, voffB);
            PG8_WAIT_V(6); PG8_BAR; PG8_MMA(1, 1, At, B1); PG8_BAR;
            PG8_LDB(B0, 1, 0); PG8_SCHED; PG8_LDA(At, 1, 0); PG8_STAGE(PG8_SA(0, 1), a2 + hstep, voffA);
            PG8_WAIT_L(8); PG8_BAR; PG8_WAIT_L(0); PG8_MMA(0, 0, At, B0); PG8_BAR; PG8_SCHED;
            PG8_LDB(B1, 1, 1); PG8_STAGE(PG8_SB(1, 0), b3, voffB);
            PG8_BAR; PG8_WAIT_L(0); PG8_MMA(0, 1, At, B1); PG8_BAR;
            PG8_LDA(At, 1, 1); PG8_STAGE(PG8_SA(1, 0), a3, voffA);
            PG8_BAR; PG8_WAIT_L(0); PG8_MMA(1, 0, At, B0); PG8_BAR; PG8_SCHED;
            PG8_STAGE(PG8_SB(1, 1), b3 + hstep, voffB);
            PG8_WAIT_V(6); PG8_BAR; PG8_MMA(1, 1, At, B1); PG8_BAR;
            }
        }
        if constexpr (ALIGN_EPI) { if (wr == 0) PG8_BAR; }
        if constexpr (!Epi::AFTER_DRAIN) { for (int er = 0; er < Epi::REPS; ++er) E(acc, cur, wr, wc, fr, fq); S.done(cur); }
        if (!has_next) break;
#pragma unroll
        for (int a = 0; a < 2; ++a)
#pragma unroll
            for (int b = 0; b < 2; ++b)
#pragma unroll
                for (int m = 0; m < 4; ++m)
#pragma unroll
                    for (int n = 0; n < 2; ++n) acc[a][b][m][n] = (f32x4){0.f, 0.f, 0.f, 0.f};
        cur = nxt; cA = nA; cB = nB; ++ui;
        if constexpr (ALIGN_EPI) { if (wr == 1) PG8_BAR; }
    }
    PG8_WAIT_V(0);
    asm volatile("" :: "v"(pfreg));
    if constexpr (!ALIGN_EPI) { if (wr == 0) PG8_BAR; }
    PG8_BAR;
    if constexpr (Epi::AFTER_DRAIN) { E.fused(acc, cur, wr, wc, fr, fq, lds, wid, lane); S.done(cur); }
#undef PG8_SA
#undef PG8_SB
#undef PG8_STAGE
#undef PG8_LDA
#undef PG8_LDB
#undef PG8_MMA
#undef PG8_WAIT_V
#undef PG8_WAIT_VL
#undef PG8_PF
#undef PG8_WAIT_L
#undef PG8_BAR
#undef PG8_SCHED
}
}
#include <hip/hip_bf16.h>
#include <cmath>
namespace attn_body {
using bf16=__hip_bfloat16;
using bf16x8=__attribute__((ext_vector_type(8)))short;
using s16x4=__attribute__((ext_vector_type(4)))short;
using f32x16=__attribute__((ext_vector_type(16)))float;
using u32x4=__attribute__((ext_vector_type(4)))unsigned;
using f32x4_t=__attribute__((ext_vector_type(4)))float;
constexpr int SEQ=4096,D=64,DM=2304,OPITCH=1024;
constexpr int NW=8,QBLK=32,QB=QBLK*NW,KVBLK=64,NQB=SEQ/QB;
constexpr int ATTN_PITCH=DM, ATTN_UNIT_ROWS=QB;
__device__ __forceinline__ int crow(int r,int hi){return (r&3)+8*(r>>2)+4*hi;}
#define SBAR() __builtin_amdgcn_sched_barrier(0)
template<bool WIN> __device__ __forceinline__ void cmask(f32x16&p0,f32x16&p1,int jb,int qrel,int hi,int q0){
  const float NEG=-INFINITY; int kb=64*jb+4*hi-(WIN?128:0);
  #pragma unroll
  for(int r=0;r<16;++r){int kv=kb+(r&3)+8*(r>>2); if(kv>qrel||(WIN&&(kv<=qrel-128||kv<-q0)))p0[r]=NEG; if(kv+32>qrel||(WIN&&(kv+32<=qrel-128||kv+32<-q0)))p1[r]=NEG;}
}

constexpr int NSLOT=3, SLOTB=8192;
constexpr int LDS_K=0, LDS_V=NSLOT*SLOTB, LDS_WS=2*NSLOT*SLOTB, LDS_OST=LDS_WS+NW*64*4, LDS_CS=LDS_OST+NW*4096, LDS_BYTES=LDS_CS+SEQ*4;
constexpr float C2=0.125f*1.4426950408889634f;
__device__ __forceinline__ void glds16(const void*gsrc,unsigned lds_dst){unsigned keep;
  asm volatile("s_mov_b32 %0, m0\n\ts_mov_b32 m0, %2\n\ts_nop 0\n\tglobal_load_lds_dwordx4 %1, off\n\ts_mov_b32 m0, %0":"=&s"(keep):"v"(gsrc),"s"(lds_dst):"memory");}
__device__ __forceinline__ float max3f(float a,float b,float c){float r;asm("v_max3_f32 %0, %1, %2, %3":"=v"(r):"v"(a),"v"(b),"v"(c));return r;}
__device__ __forceinline__ float max2f(float a,float b){float r;asm("v_max_f32_e32 %0, %1, %2":"=v"(r):"v"(a),"v"(b));return r;}
__device__ __forceinline__ float fadd_s(float a,float b){float r;asm("v_add_f32_e32 %0, %1, %2":"=v"(r):"v"(a),"v"(b));return r;}
__device__ __forceinline__ float fsub_s(float a,float b){float r;asm("v_sub_f32_e32 %0, %1, %2":"=v"(r):"v"(a),"v"(b));return r;}
typedef float f32x2_t __attribute__((ext_vector_type(2))); typedef __bf16 bf16x2_t __attribute__((ext_vector_type(2)));
__device__ __forceinline__ unsigned cvtpk_s(float lo,float hi){f32x2_t v={lo,hi};bf16x2_t b=__builtin_convertvector(v,bf16x2_t);return __builtin_bit_cast(unsigned,b);}
#define WAIT_BAR(N) asm volatile("s_waitcnt vmcnt(" #N ") lgkmcnt(0)\n\ts_barrier":::"memory")

__device__ __forceinline__ void qkt(f32x16&p0,f32x16&p1,const char*Kslot,const bf16x8*qr,int r32,int hi){
  const char*kb=Kslot+hi*1024+r32*16;
  #pragma unroll
  for(int d0=0;d0<4;++d0){
    const bf16x8 b0=*reinterpret_cast<const bf16x8*>(kb+d0*2048);
    const bf16x8 b1=*reinterpret_cast<const bf16x8*>(kb+d0*2048+512);
    p0=__builtin_amdgcn_mfma_f32_32x32x16_bf16(b0,qr[d0],p0,0,0,0);p1=__builtin_amdgcn_mfma_f32_32x32x16_bf16(b1,qr[d0],p1,0,0,0);}
}
typedef __attribute__((address_space(3))) const char* lds_cptr;
typedef short v4i16_t __attribute__((ext_vector_type(4)));
__device__ __forceinline__ void kload8(bf16x8*kf,lds_cptr kp){
  kf[0]=*(const __attribute__((address_space(3))) bf16x8*)(kp);      kf[1]=*(const __attribute__((address_space(3))) bf16x8*)(kp+512);
  kf[2]=*(const __attribute__((address_space(3))) bf16x8*)(kp+2048); kf[3]=*(const __attribute__((address_space(3))) bf16x8*)(kp+2560);
  kf[4]=*(const __attribute__((address_space(3))) bf16x8*)(kp+4096); kf[5]=*(const __attribute__((address_space(3))) bf16x8*)(kp+4608);
  kf[6]=*(const __attribute__((address_space(3))) bf16x8*)(kp+6144); kf[7]=*(const __attribute__((address_space(3))) bf16x8*)(kp+6656);
}
__device__ __forceinline__ void kload2(bf16x8*kf,lds_cptr kp,int j){ kf[2*j]=*(const __attribute__((address_space(3))) bf16x8*)(kp+j*2048); kf[2*j+1]=*(const __attribute__((address_space(3))) bf16x8*)(kp+j*2048+512); }
__device__ __forceinline__ s16x4 vtr(lds_cptr p){ return __builtin_bit_cast(s16x4,__builtin_amdgcn_ds_read_tr16_b64_v4i16((__attribute__((address_space(3))) v4i16_t*)p)); }
__device__ __forceinline__ float rowmax(const f32x16&p0,const f32x16&p1){
  float a=max3f(p0[0],p0[1],p1[0]),b=max3f(p0[2],p0[3],p1[1]);a=max3f(a,p1[2],p1[3]);
  #pragma unroll
  for(int r=4;r<16;r+=4){a=max3f(a,p0[r],p0[r+1]);b=max3f(b,p0[r+2],p0[r+3]);a=max3f(a,p1[r],p1[r+1]);b=max3f(b,p1[r+2],p1[r+3]);}
  const float m=max2f(a,b);
  auto rr=__builtin_amdgcn_permlane32_swap(__float_as_uint(m),__float_as_uint(m),false,false);
  return max2f(__uint_as_float(rr[0]),__uint_as_float(rr[1]));
}
__device__ __forceinline__ void pv(f32x16*o,int vb,bf16x8 pa0,bf16x8 pa1,bf16x8 pa2,bf16x8 pa3){
  #pragma unroll
  for(int d0=0;d0<2;++d0){s16x4 lo[4],hi[4];
    #pragma unroll
    for(int ks=0;ks<4;++ks){
      asm volatile("ds_read_b64_tr_b16 %0,%1 offset:%c2":"=&v"(lo[ks]):"v"(vb),"i"(d0*4096+ks*1024):"memory");
      asm volatile("ds_read_b64_tr_b16 %0,%1 offset:%c2":"=&v"(hi[ks]):"v"(vb),"i"(d0*4096+ks*1024+512):"memory");}
    asm volatile("s_waitcnt lgkmcnt(0)":::"memory");SBAR();
    #define PK(k) (bf16x8){lo[k][0],lo[k][1],lo[k][2],lo[k][3],hi[k][0],hi[k][1],hi[k][2],hi[k][3]}
    o[d0]=__builtin_amdgcn_mfma_f32_32x32x16_bf16(pa0,PK(0),o[d0],0,0,0);
    o[d0]=__builtin_amdgcn_mfma_f32_32x32x16_bf16(pa1,PK(1),o[d0],0,0,0);
    o[d0]=__builtin_amdgcn_mfma_f32_32x32x16_bf16(pa2,PK(2),o[d0],0,0,0);
    o[d0]=__builtin_amdgcn_mfma_f32_32x32x16_bf16(pa3,PK(3),o[d0],0,0,0);
    #undef PK
  }
}

#ifndef ATTN_STORE16
#define ATTN_STORE16(p,v) (*(u32x4*)(p)=(v))
#endif
struct AttnNext{int has,b,qb,qcol,kcol,vcol;};
template<int THRL,bool WIN> __device__ __forceinline__ void attn_unit(int b,int qb,int j0,int qcol,int kcol,int vcol,int ocol,const bf16*QKV,bf16*O,const float*cseq,float slope2,float sink2,float sink2b,
    int s0,bool head_done,bf16x8 (&qr)[4],const AttnNext nx,unsigned nxt_ticket,volatile __attribute__((address_space(3))) unsigned*qslot,const int*j0tab,const float*call,float&ctm_io,int&o_s0,unsigned&o_tk,int&o_j0,char*shm){
  int tid_l=threadIdx.x; asm volatile("":"+v"(tid_l));
  const int tid=tid_l,lane=tid&63,r32=lane&31,hi=lane>>5; const int wid=__builtin_amdgcn_readfirstlane(tid>>6);
  const long rowbase=(long)b*SEQ; const int q0=qb*(WIN?128:QB);
  const int wrow=WIN?(wid&3)*QBLK:wid*QBLK, hs=WIN?(wid>>2):0;
  const float slope2w=hs?0.5f*slope2:slope2;
  const bf16*Qw=QKV+(rowbase+q0+wrow)*DM+qcol+hs*D;
  const bf16*Kh=QKV+(rowbase+j0*KVBLK)*DM+kcol,*Vh=QKV+(rowbase+j0*KVBLK)*DM+vcol;
  const int qrel=wrow+r32;
  const int NT=(q0+(WIN?128:QB))/KVBLK-j0;
  typedef __attribute__((address_space(3))) float* lds_fptr; typedef __attribute__((address_space(3))) const f32x4_t* lds_f4ptr;
  const lds_fptr csl=(lds_fptr)(shm+LDS_CS);
  float ctm;
  const unsigned lds0=(unsigned)(uintptr_t)shm;
  float*wsf=(float*)(shm+LDS_WS)+wid*64;
  const bf16*ksrc=Kh+(long)lane*DM+wid*8;
  const bf16*vsrc=Vh+(long)(16*(wid&3)+(lane>>2))*DM+(wid>>2)*32+(lane&3)*8;
  const unsigned kdst=lds0+LDS_K+wid*1024, vdst=lds0+LDS_V+wid*1024;
  #define DMA_K(t,slot) glds16(ksrc+(long)(t)*KVBLK*DM,(unsigned)__builtin_amdgcn_readfirstlane(kdst+(slot)))
  #define DMA_V(t,slot) glds16(vsrc+(long)(t)*KVBLK*DM,(unsigned)__builtin_amdgcn_readfirstlane(vdst+(slot)))
  const int vb0=(int)(lds0+LDS_V)+((lane>>4)&1)*32+(lane&3)*8+(4*hi+((lane&15)>>2))*64;
  const char*Kbase=shm+LDS_K; bf16x8 kf[8];
  const lds_cptr shm3=(lds_cptr)shm; const lds_cptr kp0=shm3+LDS_K+hi*1024+r32*16; const lds_cptr vp0=shm3+LDS_V+((lane>>4)&1)*32+(lane&3)*8+(4*hi+((lane&15)>>2))*64;
  #define NEXTS(s) (((s)==(NSLOT-1)*SLOTB)?0:(s)+SLOTB)
  const int s1=NEXTS(s0),s2=NEXTS(s1);
  if(!head_done){DMA_K(0,s0);DMA_V(0,s0);DMA_K(1,s1);}
  if(WIN||!head_done){
  #pragma unroll
  for(int d0=0;d0<4;++d0)qr[d0]=*reinterpret_cast<const bf16x8*>(&Qw[(long)r32*DM+d0*16+hi*8]);}
  float mhat=0.f,l_reg=0.f;f32x16 o[2];o[0]=f32x16{};o[1]=f32x16{};
  #define CMASK(P0,P1,t) do{int jb_=(t)-(NT-4); if(WIN||jb_>=0)cmask<WIN>(P0,P1,jb_,qrel,hi,q0);}while(0)
  bool resc=false;
  #define START(P0,P1) do{ const float rm=rowmax(P0,P1); resc=false; \
    if(__any(rm>(float)THRL)){ const float dl=__builtin_fmaxf(rm,0.f); mhat+=dl; ctm-=dl; \
      _Pragma("unroll") for(int r=0;r<16;++r){P0[r]-=dl;P1[r]-=dl;} } \
    _Pragma("unroll") for(int r=0;r<16;++r)P0[r]=__builtin_amdgcn_exp2f(P0[r]); }while(0)
  #define BIASLD(P0,P1,tt) do{ const lds_f4ptr cp_=(lds_f4ptr)(csl+(tt)*KVBLK+4*hi); \
    _Pragma("unroll") for(int g_=0;g_<4;++g_){ const f32x4_t a_=cp_[2*g_], b_=cp_[8+2*g_]; \
      P0[4*g_]=a_[0];P0[4*g_+1]=a_[1];P0[4*g_+2]=a_[2];P0[4*g_+3]=a_[3]; P1[4*g_]=b_[0];P1[4*g_+1]=b_[1];P1[4*g_+2]=b_[2];P1[4*g_+3]=b_[3]; } }while(0)
  #define BS(x) (WIN?__builtin_fmaf(slope2w,(x),ctm):ctm-(x))
  #define BIASSUB(P0,P1) do{ _Pragma("unroll") for(int r=0;r<16;++r){P0[r]=BS(P0[r]);P1[r]=BS(P1[r]);} }while(0)
  #define RESC() do{ if(resc){ asm volatile("s_waitcnt lgkmcnt(0)":::"memory"); \
      _Pragma("unroll") for(int d_=0;d_<2;++d_) _Pragma("unroll") for(int r=0;r<16;++r)o[d_][r]*=wsf[crow(r,hi)]; } }while(0)
  f32x16 pA0,pA1,pB0,pB1;
  int sl_prev=s0,sl_cur=s0,sl_next=s1;
  #define ROT() do{sl_prev=sl_cur;sl_cur=sl_next;sl_next=(sl_next==(NSLOT-1)*SLOTB)?0:sl_next+SLOTB;}while(0)
  if(!head_done)DMA_K(2,s2);
  if(WIN){ if(!head_done){for(int k=tid;k<NT*KVBLK;k+=NW*64)csl[k]=(float)(k-128);} ctm=-slope2w*(float)qrel; }
  else if(head_done){ ctm=ctm_io; }
  else{ float cv[8]; const int nk=NT*KVBLK;
    #pragma unroll
    for(int i=0;i<8;++i){const int k=tid+i*NW*64; cv[i]=cseq[j0*KVBLK+(k<nk?k:0)];}
    ctm=cseq[q0+qrel];
    #pragma unroll
    for(int i=0;i<8;++i){const int k=tid+i*NW*64; if(k<nk)csl[k]=cv[i];} }
  WAIT_BAR(3);
  if(!WIN&&tid==0)*qslot=nxt_ticket;
  BIASLD(pA0,pA1,0); BIASSUB(pA0,pA1);
  qkt(pA0,pA1,Kbase+s0,qr,r32,hi);asm volatile("s_nop 15\n\ts_nop 7":"+v"(pA0),"+v"(pA1));CMASK(pA0,pA1,0);
  START(pA0,pA1);
  _Pragma("unroll") for(int r=0;r<16;++r)pA1[r]=__builtin_amdgcn_exp2f(pA1[r]);
  WAIT_BAR(0);
  DMA_K(3,s0);DMA_V(1,s1);
  ROT();
  kload8(kf,kp0+sl_cur);
  BIASLD(pB0,pB1,1); BIASSUB(pB0,pB1);
  WAIT_BAR(2);
  s16x4 vlo[8],vhi[8]; u32x4 pw0,pw1,pw2,pw3;
  #define PKW(P,B) cvtpk_s(P[B],P[B+1])
  #define PAF(k) __builtin_bit_cast(bf16x8,pw##k)
  #define VFR(i) (bf16x8){vlo[i][0],vlo[i][1],vlo[i][2],vlo[i][3],vhi[i][0],vhi[i][1],vhi[i][2],vhi[i][3]}
  #define PIN(x) asm volatile("":"+v"(x))
  #define MX3(a,b,c) __builtin_fmaxf(__builtin_fmaxf((a),(b)),(c))
  #define GAPA(MF,A0,A1,A2,A3,W0,W1,PW) do{ MF; sacc+=A0; sacc+=A1; sacc+=A2; sacc+=A3; PIN(sacc); W0; W1; PIN(PW); SBAR(); }while(0)
  #define EX(v) __builtin_amdgcn_exp2f(v)
  #define GAPB(MF,X,B,Y,GL) do{ MF; X[B]=EX(X[B]); X[B+1]=EX(X[B+1]); X[B+2]=EX(X[B+2]); X[B+3]=EX(X[B+3]); PIN(X); if(GL){ Y[B]=BS(Y[B]); Y[B+1]=BS(Y[B+1]); Y[B+2]=BS(Y[B+2]); Y[B+3]=BS(Y[B+3]); PIN(Y); } SBAR(); }while(0)
  #define VRD(i) do{ vlo[i]=vtr(vp_+(((i)>>2)*4096+((i)&3)*1024)); vhi[i]=vtr(vp_+(((i)>>2)*4096+((i)&3)*1024+512)); }while(0)
  #define KRD(G,j) do{ if(G){ kload2(kf,kp0+sl_next,j); SBAR(); } }while(0)
  #define STEP(C0,C1,P0,P1,t,GK,GV,GL) do{ SBAR(); \
    const lds_cptr vp_=vp0+sl_prev; \
    VRD(0); SBAR(); float sacc=(P0[0]+P0[1]); \
    GAPA(C0=__builtin_amdgcn_mfma_f32_32x32x16_bf16(kf[0],qr[0],C0,0,0,0), P0[2],P0[3],P0[4],P0[5],     pw0[0]=PKW(P0,0), pw0[1]=PKW(P0,2), pw0); \
    VRD(4); SBAR(); GAPA(C1=__builtin_amdgcn_mfma_f32_32x32x16_bf16(kf[1],qr[0],C1,0,0,0), P0[6],P0[7],P0[8],P0[9],     pw0[2]=PKW(P0,4), pw0[3]=PKW(P0,6), pw0); \
    VRD(1); SBAR(); GAPA(C0=__builtin_amdgcn_mfma_f32_32x32x16_bf16(kf[2],qr[1],C0,0,0,0),   P0[10],P0[11],P0[12],P0[13], pw1[0]=PKW(P0,8), pw1[1]=PKW(P0,10), pw1); \
    VRD(5); SBAR(); GAPA(C1=__builtin_amdgcn_mfma_f32_32x32x16_bf16(kf[3],qr[1],C1,0,0,0),   P0[14],P0[15],P1[0],P1[1],   pw1[2]=PKW(P0,12),pw1[3]=PKW(P0,14), pw1); \
    VRD(2); SBAR(); GAPA(C0=__builtin_amdgcn_mfma_f32_32x32x16_bf16(kf[4],qr[2],C0,0,0,0),   P1[2],P1[3],P1[4],P1[5],     pw2[0]=PKW(P1,0), pw2[1]=PKW(P1,2), pw2); \
    VRD(6); SBAR(); GAPA(C1=__builtin_amdgcn_mfma_f32_32x32x16_bf16(kf[5],qr[2],C1,0,0,0),   P1[6],P1[7],P1[8],P1[9],     pw2[2]=PKW(P1,4), pw2[3]=PKW(P1,6), pw2); \
    VRD(3); SBAR(); GAPA(C0=__builtin_amdgcn_mfma_f32_32x32x16_bf16(kf[6],qr[3],C0,0,0,0),   P1[10],P1[11],P1[12],P1[13], pw3[0]=PKW(P1,8), pw3[1]=PKW(P1,10), pw3); \
    VRD(7); SBAR(); GAPA(C1=__builtin_amdgcn_mfma_f32_32x32x16_bf16(kf[7],qr[3],C1,0,0,0),   P1[14],P1[15],0.f,0.f,       pw3[2]=PKW(P1,12),pw3[3]=PKW(P1,14), pw3); \
    l_reg+=sacc; \
    if(GL){ BIASLD(P0,P1,(t)+1); SBAR(); } \
    if(GK){DMA_K((t)+3,sl_cur);} if(GV){DMA_V((t)+1,sl_next);} \
    CMASK(C0,C1,t); \
    { float a=MX3(C0[0],C0[1],C1[0]),b=MX3(C0[2],C0[3],C1[1]); a=MX3(a,C1[2],C1[3]); \
      _Pragma("unroll") for(int r=4;r<16;r+=4){a=MX3(a,C0[r],C0[r+1]);b=MX3(b,C0[r+2],C0[r+3]);a=MX3(a,C1[r],C1[r+1]);b=MX3(b,C1[r+2],C1[r+3]);} \
      float rm=__builtin_fmaxf(a,b); { auto rr=__builtin_amdgcn_permlane32_swap(__float_as_uint(rm),__float_as_uint(rm),false,false); rm=__builtin_fmaxf(__uint_as_float(rr[0]),__uint_as_float(rr[1])); } \
      resc=false; \
      if(__builtin_expect(__any(rm>(float)THRL),0)){ const float dl=__builtin_fmaxf(rm,0.f); mhat+=dl; ctm-=dl; \
        _Pragma("unroll") for(int r=0;r<16;++r){C0[r]-=dl;C1[r]-=dl;} \
        const float f=__builtin_amdgcn_exp2f(-dl); l_reg*=f; if(hi==0)wsf[r32]=f; resc=true; } } \
    SBAR(); \
    GAPB(o[0]=__builtin_amdgcn_mfma_f32_32x32x16_bf16(PAF(0),VFR(0),o[0],0,0,0), C0,0,P0,GL); \
    GAPB(o[1]=__builtin_amdgcn_mfma_f32_32x32x16_bf16(PAF(0),VFR(4),o[1],0,0,0), C0,4,P0,GL); \
    KRD(GL,0); GAPB(o[0]=__builtin_amdgcn_mfma_f32_32x32x16_bf16(PAF(1),VFR(1),o[0],0,0,0), C0,8,P0,GL); \
    KRD(GL,1); GAPB(o[1]=__builtin_amdgcn_mfma_f32_32x32x16_bf16(PAF(1),VFR(5),o[1],0,0,0), C0,12,P0,GL); \
    KRD(GL,2); GAPB(o[0]=__builtin_amdgcn_mfma_f32_32x32x16_bf16(PAF(2),VFR(2),o[0],0,0,0), C1,0,P1,GL); \
    KRD(GL,3); GAPB(o[1]=__builtin_amdgcn_mfma_f32_32x32x16_bf16(PAF(2),VFR(6),o[1],0,0,0), C1,4,P1,GL); \
    GAPB(o[0]=__builtin_amdgcn_mfma_f32_32x32x16_bf16(PAF(3),VFR(3),o[0],0,0,0), C1,8,P1,GL); \
    GAPB(o[1]=__builtin_amdgcn_mfma_f32_32x32x16_bf16(PAF(3),VFR(7),o[1],0,0,0), C1,12,P1,GL); \
    }while(0)
  int t=1; unsigned tk=0xffffffffu; int jnv=0;
  #undef CMASK
  #define CMASK(P0,P1,t) do{}while(0)
  for(;t+5<NT;t+=2){
    STEP(pB0,pB1,pA0,pA1,t,true,true,true);     WAIT_BAR(2); RESC(); ROT();
    STEP(pA0,pA1,pB0,pB1,t+1,true,true,true);   WAIT_BAR(2); RESC(); ROT();
  }
  #undef CMASK
  #define CMASK(P0,P1,t) do{int jb_=(t)-(NT-4); if(WIN||jb_>=0)cmask<WIN>(P0,P1,jb_,qrel,hi,q0);}while(0)
  #define ENDW(tt) do{ if((tt)+3<NT){WAIT_BAR(2);} else if((tt)+2<NT){WAIT_BAR(1);} else {WAIT_BAR(0);} }while(0)
  for(;t+1<NT;t+=2){
    STEP(pB0,pB1,pA0,pA1,t,(t+3<NT),(t+1<NT),(t+1<NT));       ENDW(t);   RESC(); ROT();
    if(!WIN&&t+3==NT){ tk=(unsigned)__builtin_amdgcn_readfirstlane((int)*qslot); if(tk<2048u)jnv=j0tab[(tk&127u)*16u+(15u-(tk>>7))]; }
    STEP(pA0,pA1,pB0,pB1,t+1,(t+4<NT),(t+2<NT),(t+2<NT));     ENDW(t+1); RESC(); ROT();
  }
  const int s0n=sl_next; bool hn; int nb_,nqb_,nqc,nkc,nvc,nj0;
  if(WIN){hn=nx.has!=0;nb_=nx.b;nqb_=nx.qb;nqc=nx.qcol;nkc=nx.kcol;nvc=nx.vcol;nj0=2*nx.qb-2;}
  else{hn=tk<2048u;const int nbh=(int)(tk&127u),nhb=nbh&7;nb_=nbh>>3;nqb_=15-(int)(tk>>7);nqc=768+nhb*64;nkc=1280+nhb*64;nvc=1792+nhb*64;nj0=__builtin_amdgcn_readfirstlane(jnv);}
  if(hn){ const bf16*kn_=QKV+((long)nb_*SEQ+(long)nj0*KVBLK)*DM+nkc+(long)lane*DM+wid*8; const bf16*vn_=QKV+((long)nb_*SEQ+(long)nj0*KVBLK)*DM+nvc+(long)(16*(wid&3)+(lane>>2))*DM+(wid>>2)*32+(lane&3)*8;
    const int sb_=NEXTS(s0n),sc_=NEXTS(sb_);
    glds16(kn_,(unsigned)__builtin_amdgcn_readfirstlane(kdst+s0n)); glds16(vn_,(unsigned)__builtin_amdgcn_readfirstlane(vdst+s0n));
    glds16(kn_+(long)KVBLK*DM,(unsigned)__builtin_amdgcn_readfirstlane(kdst+sb_)); glds16(kn_+2L*KVBLK*DM,(unsigned)__builtin_amdgcn_readfirstlane(kdst+sc_)); }
  o_s0=s0n; o_tk=tk; o_j0=nj0;
  STEP(pB0,pB1,pA0,pA1,NT-1,false,false,false); RESC();
  { float sacc=pB0[0]+pB0[1]; _Pragma("unroll") for(int r=2;r<16;++r)sacc+=pB0[r]; _Pragma("unroll") for(int r=0;r<16;++r)sacc+=pB1[r]; l_reg+=sacc;
    pw0=(u32x4){PKW(pB0,0),PKW(pB0,2),PKW(pB0,4),PKW(pB0,6)};pw1=(u32x4){PKW(pB0,8),PKW(pB0,10),PKW(pB0,12),PKW(pB0,14)};pw2=(u32x4){PKW(pB1,0),PKW(pB1,2),PKW(pB1,4),PKW(pB1,6)};pw3=(u32x4){PKW(pB1,8),PKW(pB1,10),PKW(pB1,12),PKW(pB1,14)};
    SBAR(); pv(o,vb0+sl_cur,PAF(0),PAF(1),PAF(2),PAF(3)); }
  if(!WIN&&hn){ const bf16*qn_=QKV+((long)nb_*SEQ+(long)nqb_*(WIN?128:QB)+wrow)*DM+nqc+hs*D;
    #pragma unroll
    for(int d0=0;d0<4;++d0)qr[d0]=*reinterpret_cast<const bf16x8*>(&qn_[(long)r32*DM+d0*16+hi*8]); }
  float cvn[8]; float ctmn=0.f; int nkn=0;
  if(!WIN&&hn){ const float*cn=call+(size_t)(tk&127u)*SEQ; nkn=((nqb_*QB+QB)/KVBLK-nj0)*KVBLK;
    #pragma unroll
    for(int i=0;i<8;++i){const int k=tid+i*NW*64; cvn[i]=cn[nj0*KVBLK+(k<nkn?k:0)];}
    ctmn=cn[nqb_*QB+qrel]; }
  #undef PKW
  #undef PAF
  #undef VFR
  #undef PIN
  #undef MX3
  #undef GAPA
  #undef GAPB
  #undef EX
  #undef VRD
  #undef KRD
  #undef STEP
  #undef ENDW
  {auto rr=__builtin_amdgcn_permlane32_swap(__float_as_uint(l_reg),__float_as_uint(l_reg),false,false);l_reg=__uint_as_float(rr[0])+__uint_as_float(rr[1]);}
  if(WIN)l_reg+=__builtin_amdgcn_exp2f((hs?sink2b:sink2)-mhat);
  if(hi==0)wsf[32+r32]=l_reg;asm volatile("s_waitcnt lgkmcnt(0)":::"memory");
  float rli[16];
  #pragma unroll
  for(int r=0;r<16;++r)rli[r]=__builtin_amdgcn_rcpf(wsf[32+crow(r,hi)]);
  bf16*Ow=O+(rowbase+q0+wrow)*OPITCH+ocol+hs*D;
  { bf16*stg=(bf16*)(shm+LDS_OST)+wid*2048;
    #pragma unroll
    for(int r=0;r<16;++r){const int orow=crow(r,hi);
      #pragma unroll
      for(int d0=0;d0<2;++d0)stg[orow*64+d0*32+r32]=__float2bfloat16(o[d0][r]*rli[r]);}
    asm volatile("s_waitcnt lgkmcnt(0)":::"memory");
    #pragma unroll
    for(int i=0;i<4;++i){const int row=i*8+(lane>>3),ch=lane&7; const u32x4 v=*(const u32x4*)(stg+row*64+ch*8); ATTN_STORE16(Ow+(long)row*OPITCH+ch*8,v);} }
  if(!WIN&&hn){
    #pragma unroll
    for(int i=0;i<8;++i){const int k=tid+i*NW*64; if(k<nkn)csl[k]=cvn[i];} }
  ctm_io=ctmn;
  asm volatile("s_waitcnt lgkmcnt(0)\n\ts_barrier":::"memory");
  #undef DMA_K
  #undef DMA_V
  #undef CMASK
  #undef START
  #undef RESC
  #undef BIASLD
  #undef BIASSUB
  #undef BS
  #undef ROT
  #undef NEXTS
}
constexpr int ATTN_LDS_BYTES=LDS_BYTES;
#undef SBAR
#undef WAIT_BAR
}
#define GAS __attribute__((address_space(1)))
#define LAS __attribute__((address_space(3)))
typedef unsigned short bf16;
typedef unsigned v4u __attribute__((ext_vector_type(4)));
typedef float f32x4 __attribute__((ext_vector_type(4)));
constexpr int NWAVES = 8;
constexpr int BATCH = 16, SEQ = 4096, D = 1024, FF = 4096, M = BATCH * SEQ, NIN = 2312, NINP = 2304, QKVP = 2304;
constexpr float EPS = 1e-6f, LOG2E = 1.4426950408889634f;
constexpr size_t MiB = 1u << 20;
constexpr size_t WS_ROWSS = 0  , WS_C = 1 * MiB, WS_WIN = 4 * MiB, WS_WOUT = 10 * MiB, WS_WUP = 12 * MiB, WS_WDN = 20 * MiB;
constexpr size_t WS_XN = 32 * MiB  , WS_QKV = 160 * MiB  , WS_MIX = 672 * MiB  , WS_HID = 160 * MiB  , WS_END = 800 * MiB;
constexpr int RING_BYTES = 131072, LDS_BYTES = 147456;
constexpr size_t WS_BAR = 3 * MiB;
constexpr size_t WS_QCTR = WS_BAR + 16384, CTL_ZERO_BYTES = 16384 + 256;
constexpr size_t WS_J0 = 3 * MiB + 512 * 1024;
constexpr size_t WS_XMAP = 3 * MiB + 64 * 1024;
constexpr int MISC_OFF = RING_BYTES + 320;
#define LDS_WAIT() asm volatile("s_waitcnt lgkmcnt(0)" ::: "memory")
__device__ __forceinline__ unsigned f2bf(float f) { unsigned u = __builtin_bit_cast(unsigned, f); return (u + 0x7fffu + ((u >> 16) & 1u)) >> 16; }
__device__ __forceinline__ unsigned pk2(float lo, float hi) { return f2bf(lo) | (f2bf(hi) << 16); }
__device__ __forceinline__ float bf2f(unsigned short b) { return __builtin_bit_cast(float, (unsigned)b << 16); }
__device__ __forceinline__ float wave_sum(float v) {
#pragma unroll
    for (int o = 1; o < 64; o <<= 1) v += __shfl_xor(v, o);
    return v;
}
#define XB_TMO      128
#define XB_XCNT(j)  (256  + 64 * (j))
#define XB_XSUB(j)  (1280 + 64 * (j))
#define XB_XGEN(j)  (2304 + 64 * (j))
#define XB_TOP      3328
#define XB_TOPGEN   3392
#define XCD_BAR_WORDS 3456
#define XB_SPIN_CAP (1u << 18)

__device__ __forceinline__ unsigned xb_ld(unsigned* p)              { return __hip_atomic_load(p, __ATOMIC_RELAXED, __HIP_MEMORY_SCOPE_AGENT); }
__device__ __forceinline__ unsigned xb_add(unsigned* p, unsigned v) { return __hip_atomic_fetch_add(p, v, __ATOMIC_RELAXED, __HIP_MEMORY_SCOPE_AGENT); }
__device__ __forceinline__ unsigned xb_xcc_id() { return (unsigned)__builtin_amdgcn_s_getreg((3 << 11) | 20) & 0xFu; }
#define XB_SPIN(cond, bar) do { unsigned _sp = 0; while (cond) { __builtin_amdgcn_s_sleep(1); \
    if ((++_sp & 255u) == 0u) { if (xb_ld(&(bar)[XB_TMO])) break; if (_sp > XB_SPIN_CAP) { atomicAdd(&(bar)[XB_TMO], 1u); break; } } } } while (0)

struct XcdBarrier {
    unsigned* bar; unsigned x;
    volatile LAS unsigned* st;
};

__device__ __forceinline__ XcdBarrier xcd_barrier_post(unsigned* bar, volatile LAS unsigned* st) {
    XcdBarrier b; b.bar = bar; b.x = xb_xcc_id(); b.st = st;
    if (threadIdx.x == 0) (void)xb_add(&bar[XB_XCNT(b.x)], 1u);
    return b;
}
__device__ __forceinline__ void xcd_barrier_complete(unsigned* bar, unsigned x, unsigned& nloc, unsigned& nx) {
    const unsigned G = gridDim.x * gridDim.y * gridDim.z;
    unsigned sum, cnt, mine, sp = 0u;
    for (;;) {
        sum = 0u; cnt = 0u; mine = 0u;
#pragma unroll
        for (unsigned j = 0; j < 16; ++j) { const unsigned c = xb_ld(&bar[XB_XCNT(j)]); sum += c; cnt += (c > 0u) ? 1u : 0u; mine = (j == x) ? c : mine; }
        if (sum == G) break;
        __builtin_amdgcn_s_sleep(1);
        if ((++sp & 255u) == 0u) { if (xb_ld(&bar[XB_TMO])) break; if (sp > XB_SPIN_CAP) { atomicAdd(&bar[XB_TMO], 1u); break; } }
    }
    nloc = mine > 0u ? mine : 1u; nx = cnt > 0u ? cnt : 1u;
}

__device__ __forceinline__ void xcd_barrier(const XcdBarrier& b) {
    asm volatile("s_waitcnt vmcnt(0)" ::: "memory");
    __syncthreads();
    if (threadIdx.x == 0) {
        unsigned* bar = b.bar;
        __builtin_amdgcn_s_waitcnt(0);
        unsigned nloc = b.st[0], nx = b.st[1];
        if (nloc == 0u) { xcd_barrier_complete(bar, b.x, nloc, nx); b.st[0] = nloc; b.st[1] = nx; }
        const unsigned old = xb_add(&bar[XB_XSUB(b.x)], 1u);
        const unsigned gen = old / nloc;
        if (old + 1u == (gen + 1u) * nloc) {
            __builtin_amdgcn_fence(__ATOMIC_RELEASE, "agent");
            asm volatile("s_waitcnt vmcnt(0)" ::: "memory");
            const unsigned og = xb_add(&bar[XB_TOP], 1u);
            const unsigned tg = og / nx;
            if (og + 1u == (tg + 1u) * nx) xb_add(&bar[XB_TOPGEN], 1u);
            else XB_SPIN(xb_ld(&bar[XB_TOPGEN]) == tg, bar);
            __builtin_amdgcn_fence(__ATOMIC_ACQUIRE, "agent");
            xb_add(&bar[XB_XGEN(b.x)], 1u);
            asm volatile("s_waitcnt vmcnt(0)" ::: "memory");
        } else {
            XB_SPIN(xb_ld(&bar[XB_XGEN(b.x)]) == gen, bar);
            __builtin_amdgcn_fence(__ATOMIC_ACQUIRE, "agent");
            asm volatile("s_waitcnt vmcnt(0)" ::: "memory");
        }
    }
    __syncthreads();
}

__device__ __forceinline__ void xcd_barrier_local(const XcdBarrier& b) {
    asm volatile("s_waitcnt vmcnt(0)" ::: "memory");
    __syncthreads();
    if (threadIdx.x == 0) {
        unsigned* bar = b.bar;
        __builtin_amdgcn_s_waitcnt(0);
        const unsigned nloc = b.st[0];
        const unsigned old = xb_add(&bar[XB_XSUB(b.x)], 1u);
        const unsigned gen = old / nloc;
        if (old + 1u == (gen + 1u) * nloc) xb_add(&bar[XB_XGEN(b.x)], 1u);
        else XB_SPIN(xb_ld(&bar[XB_XGEN(b.x)]) == gen, bar);
        __builtin_amdgcn_fence(__ATOMIC_ACQUIRE, "agent");
        asm volatile("s_waitcnt vmcnt(0)" ::: "memory");
    }
    __syncthreads();
}

__device__ __forceinline__ void p0_transpose_item(const float* W, int K, int N, int nvalid, bf16* WT, int dest_row0, int k0, int n0, const float* kscale, LAS float* scr, int lane) {
    const int col = n0 + (lane & 31);
#pragma unroll
    for (int i = 0; i < 32; ++i) { const int kk = 2 * i + (lane >> 5); float v = col < nvalid ? W[(size_t)(k0 + kk) * N + col] : 0.f; if (kscale) v *= kscale[k0 + kk]; scr[kk * 33 + (lane & 31)] = v; }
    LDS_WAIT(); asm volatile("" ::: "memory");
    const int c = lane & 7;
#pragma unroll
    for (int j = 0; j < 4; ++j) { const int n = (lane >> 3) + 8 * j; const LAS float* s = scr + (8 * c) * 33 + n;
        v4u o; o.x = pk2(s[0 * 33], s[1 * 33]); o.y = pk2(s[2 * 33], s[3 * 33]); o.z = pk2(s[4 * 33], s[5 * 33]); o.w = pk2(s[6 * 33], s[7 * 33]);
        *(GAS v4u*)(WT + (size_t)(dest_row0 + n) * K + k0 + 8 * c) = o; }
    LDS_WAIT(); asm volatile("" ::: "memory");
}
template <int NR> __device__ __forceinline__ void rms_rows_to_bf16(const float* x, const float* g, bf16* o, int m0, int mstride, int lane, const f32x4 (&wf)[4][4][2], const float* bfg, float* carr) {
    f32x4 v[NR][4];
#pragma unroll
    for (int r = 0; r < NR; ++r) { const GAS f32x4* xr = (const GAS f32x4*)(x + (size_t)(m0 + r * mstride) * D) + lane;
#pragma unroll
        for (int j = 0; j < 4; ++j) v[r][j] = xr[64 * j]; }
    f32x4 gg[4]; { const GAS f32x4* gr = (const GAS f32x4*)g + lane;
#pragma unroll
        for (int j = 0; j < 4; ++j) gg[j] = gr[64 * j]; }
    const bool up32 = (lane & 32) != 0, up16 = (lane & 16) != 0, up8 = (lane & 8) != 0;
    const int hh = (up32 ? 4 : 0) + (up16 ? 2 : 0) + (up8 ? 1 : 0); const float bh = bfg[hh];
#pragma unroll
    for (int r = 0; r < NR; ++r) { float s = 0.f; const int m = m0 + r * mstride;
#pragma unroll
        for (int j = 0; j < 4; ++j) s += (v[r][j].x * v[r][j].x + v[r][j].y * v[r][j].y) + (v[r][j].z * v[r][j].z + v[r][j].w * v[r][j].w);
        const float rstd = rsqrtf(wave_sum(s) * (1.f / D) + EPS);
        GAS unsigned long long* o8 = (GAS unsigned long long*)(o + (size_t)m * D) + lane;
        f32x4 a0 = {0.f, 0.f, 0.f, 0.f}, a1 = {0.f, 0.f, 0.f, 0.f};
#pragma unroll
        for (int j = 0; j < 4; ++j) { const f32x4 xn = v[r][j] * rstd * gg[j];
            o8[64 * j] = (unsigned long long)pk2(xn.x, xn.y) | ((unsigned long long)pk2(xn.z, xn.w) << 32);
#pragma unroll
            for (int e = 0; e < 4; ++e) { a0 += wf[j][e][0] * xn[e]; a1 += wf[j][e][1] * xn[e]; } }
        f32x4 k4 = up32 ? a1 : a0, s4 = up32 ? a0 : a1;
#pragma unroll
        for (int e = 0; e < 4; ++e) k4[e] += __shfl_xor(s4[e], 32);
        float k2a = up16 ? k4[2] : k4[0], k2b = up16 ? k4[3] : k4[1]; const float s2a = up16 ? k4[0] : k4[2], s2b = up16 ? k4[1] : k4[3];
        k2a += __shfl_xor(s2a, 16); k2b += __shfl_xor(s2b, 16);
        float k1 = up8 ? k2b : k2a; const float s1 = up8 ? k2a : k2b;
        k1 += __shfl_xor(s1, 8); k1 += __shfl_xor(k1, 4); k1 += __shfl_xor(k1, 2); k1 += __shfl_xor(k1, 1);
        if ((lane & 7) == 0) { const float z = k1 + bh; carr[(size_t)((m >> 12) * 8 + hh) * SEQ + (m & (SEQ - 1))] = fminf(z, 0.f) - log1pf(expf(-fabsf(z))); } }
}
struct Args { const float* in[13]; float* out; unsigned char* ws; };
__device__ __forceinline__ void p0_prologue(const Args& a, unsigned char* ws, LAS unsigned char* lds, int vcu, int G, int wave, int lane) {
    LAS float* scr = (LAS float*)(lds + wave * 16384);
    const int gw = vcu * NWAVES + wave, NGW = G * NWAVES;
    const float *w_in = a.in[2], *w_out = a.in[9], *w_up = a.in[11], *w_dn = a.in[12], *g2 = a.in[10];
    bf16 *Win = (bf16*)(ws + WS_WIN), *Wout = (bf16*)(ws + WS_WOUT), *Wup = (bf16*)(ws + WS_WUP), *Wdn = (bf16*)(ws + WS_WDN);
    constexpr int I_IN = 16 * 72, I_OUT = 16 * 32, I_UP = 16 * 128, I_DN = 64 * 32, NITEMS = I_IN + I_OUT + I_UP + I_DN;
    for (int it = gw; it < NITEMS; it += NGW) {
        int r = it;
        if (r < I_IN) { const int kb = r / 72, nb = r % 72, n0 = 32 * nb;
            const int dest = ((n0 >> 8) << 8) + (((n0 & 63) >> 5) << 7) + (((n0 & 255) >> 6) << 5);
            p0_transpose_item(w_in, D, NIN, NIN, Win, dest, 64 * kb, n0, nullptr, scr, lane); continue; } r -= I_IN;
        if (r < I_OUT) { p0_transpose_item(w_out, D, D, D, Wout, 32 * (r % 32), 64 * (r / 32), 32 * (r % 32), nullptr, scr, lane); continue; } r -= I_OUT;
        if (r < I_UP) { p0_transpose_item(w_up, D, FF, FF, Wup, 32 * (r % 128), 64 * (r / 128), 32 * (r % 128), g2, scr, lane); continue; } r -= I_UP;
        p0_transpose_item(w_dn, FF, D, D, Wdn, 32 * (r % 32), 64 * (r / 32), 32 * (r % 32), nullptr, scr, lane);
    }
    const float* x = a.in[0]; const float* g1 = a.in[1]; bf16* XN = (bf16*)(ws + WS_XN);
    f32x4 wf[4][4][2];
#pragma unroll
    for (int j = 0; j < 4; ++j)
#pragma unroll
        for (int e = 0; e < 4; ++e) { const float* wp = w_in + (size_t)(4 * lane + 256 * j + e) * NIN + QKVP; wf[j][e][0] = *(const f32x4*)wp; wf[j][e][1] = *(const f32x4*)(wp + 4); }
    float* carr = (float*)(ws + WS_C);
    { int m = gw; for (; m + 3 * NGW < M; m += 4 * NGW) rms_rows_to_bf16<4>(x, g1, XN, m, NGW, lane, wf, a.in[3], carr); for (; m < M; m += NGW) rms_rows_to_bf16<1>(x, g1, XN, m, NGW, lane, wf, a.in[3], carr); }
}
__device__ __forceinline__ void scan_seq(float* seq, int* j0row, float skipthr, LAS float* scr, int tid, int wave, int lane) {
    f32x4 a = *(const f32x4*)(seq + 8 * tid), b = *(const f32x4*)(seq + 8 * tid + 4);
    a[1] += a[0]; a[2] += a[1]; a[3] += a[2]; b[0] += a[3]; b[1] += b[0]; b[2] += b[1]; b[3] += b[2];
    float tot = b[3], inc = tot;
#pragma unroll
    for (int o = 1; o < 64; o <<= 1) { const float t = __shfl_up(inc, o); if (lane >= o) inc += t; }
    if (lane == 63) scr[wave] = inc;
    __syncthreads();
    float base = inc - tot;
    for (int w = 0; w < wave; ++w) base += scr[w];
    a = (a + base) * LOG2E; b = (b + base) * LOG2E;
    *(f32x4*)(seq + 8 * tid) = a; *(f32x4*)(seq + 8 * tid + 4) = b;
    if ((tid & 7) == 7) scr[16 + (tid >> 3)] = b[3];
    if ((tid & 31) == 0) scr[96 + (tid >> 5)] = a[0];
    __syncthreads();
#pragma unroll
    for (int k = 0; k < 2; ++k) { const int qb = 2 * wave + k, NTf = 4 * qb + 4; const float cq = scr[96 + qb], ce = scr[16 + lane];
        const unsigned long long need = __ballot(lane < NTf && ce <= cq + skipthr);
        int jf = need ? (int)__ffsll((long long)need) - 1 : NTf; jf &= ~1; if (jf > NTf - 4) jf = NTf - 4;
        if (lane == 0) j0row[qb] = jf; }
    __syncthreads();
}
#define WSP(T, off) ((T*)(args.ws + (off)))
__global__ void __launch_bounds__(NWAVES * 64, 2) fwd_kernel(Args args) {
    extern __shared__ __attribute__((aligned(16))) unsigned char lds_raw[];
    cg::grid_group grid = cg::this_grid();
    LAS unsigned char* lds = (LAS unsigned char*)lds_raw;
    const int tid = threadIdx.x, lane = tid & 63, wave = __builtin_amdgcn_readfirstlane(tid >> 6);
    const int G = gridDim.x, bx = blockIdx.x, vcu = (G % 8 == 0) ? (bx % 8) * (G / 8) + bx / 8 : bx;
    constexpr bool ALIGN = true, SP2 = true;
    volatile LAS unsigned* bst = (volatile LAS unsigned*)(lds + MISC_OFF);
    if (tid == 0) { bst[0] = 0u; bst[1] = 0u; }
    unsigned* barw = WSP(unsigned, WS_BAR);
    const XcdBarrier xbar = xcd_barrier_post(barw, bst);
    if (tid == 0) WSP(unsigned, WS_XMAP)[bx] = xbar.x;
    if (args.ws == nullptr) grid.sync();

    p0_prologue(args, args.ws, lds, vcu, G, wave, lane);
    xcd_barrier(xbar);
    bool local_seams;
    { const unsigned* xm = WSP(unsigned, WS_XMAP); int ok = (G % 8 == 0) && (G <= NWAVES * 64);
      if (ok && tid < G) ok = xm[tid] == xm[tid & 7];
      if (ok && tid < 8) ok = xb_ld(&barw[XB_XCNT(xm[tid] & 15u)]) == (unsigned)(G / 8);
      local_seams = __syncthreads_and(ok) != 0; }

    float skipthr;
    { float mq = fabsf(args.in[7][lane]), mk = fabsf(args.in[8][lane]);
#pragma unroll
      for (int o = 1; o < 64; o <<= 1) { mq = fmaxf(mq, __shfl_xor(mq, o)); mk = fmaxf(mk, __shfl_xor(mk, o)); }
      skipthr = 2.f * (8.f * mq * mk * LOG2E * 1.01f) + 50.f; }
    for (int i = bx; i < BATCH * 8; i += G) scan_seq(WSP(float, WS_C) + (size_t)i * SEQ, WSP(int, WS_J0) + i * 16, skipthr, (LAS float*)lds, tid, wave, lane);
    { pg8::Gemm g{WSP(bf16, WS_XN), WSP(bf16, WS_WIN), M, NINP, D}; pg8::StaticOrder S; S.init(M, NINP, G, bx);
      pg8::EpiInProj E{WSP(bf16, WS_QKV), args.in[4], args.in[5], args.in[7], args.in[8]};
      pg8::gemm_phase<pg8::EpiInProj, pg8::StaticOrder, ALIGN, SP2>(lds, g, S, E); }
    xcd_barrier(xbar);

    float ctmc = 0.f;
    attn_body::bf16x8 qfr[4] = {};
    volatile LAS unsigned* qslot = (volatile LAS unsigned*)(lds + MISC_OFF + 64);
    { const int NU = BATCH * 2 * 2 * 32, per = (NU + G - 1) / G; int s0 = 0; bool hd = false;
      for (int i = 0; i < per; ++i) { const int u = vcu * per + i; if (u >= NU) break; const int qb = u & 31, pr = (u >> 5) & 1, kvh = (u >> 6) & 1, b = u >> 7, h0 = 4 * kvh + 2 * pr;
          const int un = u + 1; const bool hasn = (i + 1 < per) && (un < NU); const int nkvh = (un >> 6) & 1, nh0 = 4 * nkvh + 2 * ((un >> 5) & 1);
          const attn_body::AttnNext nx{hasn ? 1 : 0, un >> 7, un & 31, nh0 * 64, 512 + nkvh * 64, 640 + nkvh * 64};
          int s0n = 0, j0n = 0; unsigned tkn = 0u;
          attn_body::attn_unit<16, true>(b, qb, 2 * qb - 2, h0 * 64, 512 + kvh * 64, 640 + kvh * 64, h0 * 64, (const attn_body::bf16*)WSP(bf16, WS_QKV), (attn_body::bf16*)WSP(bf16, WS_MIX), nullptr,
                                         exp2f(-(float)(h0 + 1)) * LOG2E, args.in[6][h0] * LOG2E, args.in[6][h0 + 1] * LOG2E, s0, hd, qfr, nx, 0u, qslot, nullptr, nullptr, ctmc, s0n, tkn, j0n, (char*)lds_raw);
          s0 = s0n; hd = hasn; } }
    { const int NU = BATCH * 8 * 16; unsigned* qctr = WSP(unsigned, WS_QCTR); const int* j0tab = WSP(int, WS_J0);
      int u = bx, s0 = 0; bool hd = false;
      int j0 = u < NU ? j0tab[(u & 127) * 16 + (15 - (u >> 7))] : 0;
      while (u < NU) {
          unsigned nxt = 0u;
          if (tid == 0) nxt = (unsigned)G + __hip_atomic_fetch_add(qctr, 1u, __ATOMIC_RELAXED, __HIP_MEMORY_SCOPE_AGENT);
          const int bh = u & 127, qb = 15 - (u >> 7), hb = bh & 7;
          int s0n = 0, j0n = 0; unsigned tkn = 0xffffffffu;
          attn_body::attn_unit<16, false>(bh >> 3, qb, __builtin_amdgcn_readfirstlane(j0), 768 + hb * 64, 1280 + hb * 64, 1792 + hb * 64, 512 + hb * 64, (const attn_body::bf16*)WSP(bf16, WS_QKV), (attn_body::bf16*)WSP(bf16, WS_MIX),
                                          WSP(float, WS_C) + (size_t)bh * SEQ, 0.f, 0.f, 0.f, s0, hd, qfr, attn_body::AttnNext{0, 0, 0, 0, 0, 0}, nxt, qslot, j0tab, WSP(float, WS_C), ctmc, s0n, tkn, j0n, (char*)lds_raw);
          u = tkn < (unsigned)NU ? (int)tkn : NU; j0 = j0n; s0 = s0n; hd = u < NU;
      } }
    xcd_barrier(xbar);

    { pg8::Gemm g{WSP(bf16, WS_MIX), WSP(bf16, WS_WOUT), M, D, D}; pg8::StaticOrder S; S.init(M, D, G, bx);
      pg8::EpiOutProj E{args.in[0], WSP(bf16, WS_XN), WSP(float, WS_ROWSS), (PG8_LAS float*)(lds + RING_BYTES + 1024)};
      pg8::gemm_phase<pg8::EpiOutProj, pg8::StaticOrder, ALIGN, SP2>(lds, g, S, E); }
    if (local_seams) xcd_barrier_local(xbar); else xcd_barrier(xbar);

    { pg8::Gemm g{WSP(bf16, WS_XN), WSP(bf16, WS_WUP), M, FF, D}; pg8::StaticOrder S; S.init(M, FF, G, bx, pg8::WGM, (M / 256 * (FF / 256)) % G == 0 ? 1 : 0);
      pg8::EpiUp E{WSP(bf16, WS_HID), WSP(float, WS_ROWSS)};
      pg8::gemm_phase<pg8::EpiUp, pg8::StaticOrder, ALIGN, SP2>(lds, g, S, E); }
    if (local_seams) xcd_barrier_local(xbar); else xcd_barrier(xbar);

    { pg8::Gemm g{WSP(bf16, WS_HID), WSP(bf16, WS_WDN), M, D, FF}; pg8::StaticOrder S; S.init(M, D, G, bx);
      pg8::EpiDown E{WSP(bf16, WS_XN), args.out};
      pg8::gemm_phase<pg8::EpiDown, pg8::StaticOrder, ALIGN, SP2>(lds, g, S, E); }
}
#undef WSP
extern "C" void kernel_launch(void* const* d_in, const int* in_sizes, int n_in, void* d_out, int out_size, void* d_ws, size_t ws_size, hipStream_t stream) {
    static int grid = 0;
    if (grid == 0) {
        if (n_in != 13 || in_sizes[0] != M * D || out_size != M * D || ws_size < WS_END) { fprintf(stderr, "kernel_launch: unexpected shapes (n_in %d, in0 %d, out %d, ws %zu)\n", n_in, n_in > 0 ? in_sizes[0] : -1, out_size, ws_size); grid = -1; return; }
        int dev = 0, cus = 0, per_cu = 0;
        if (hipGetDevice(&dev) != hipSuccess || hipDeviceGetAttribute(&cus, hipDeviceAttributeMultiprocessorCount, dev) != hipSuccess) { grid = -1; return; }
        if (hipFuncSetAttribute((const void*)fwd_kernel, hipFuncAttributeMaxDynamicSharedMemorySize, LDS_BYTES) != hipSuccess) { fprintf(stderr, "kernel_launch: hipFuncSetAttribute failed\n"); grid = -1; return; }
        if (hipOccupancyMaxActiveBlocksPerMultiprocessor(&per_cu, (const void*)fwd_kernel, NWAVES * 64, LDS_BYTES) != hipSuccess || per_cu < 1) { fprintf(stderr, "kernel_launch: occupancy query gives %d\n", per_cu); per_cu = 1; }
        (void)hipGetLastError();
        grid = cus * per_cu;
    }
    if (grid < 0) return;
    if (hipMemsetAsync((char*)d_ws + WS_BAR, 0, CTL_ZERO_BYTES, stream) != hipSuccess) { fprintf(stderr, "kernel_launch: hipMemsetAsync of the control words failed; nothing launched\n"); return; }
    Args a{};
    for (int i = 0; i < 13; ++i) a.in[i] = (const float*)d_in[i];
    a.out = (float*)d_out; a.ws = (unsigned char*)d_ws;
    void* params[] = {&a};
    hipError_t e = hipLaunchCooperativeKernel((const void*)fwd_kernel, dim3(grid), dim3(NWAVES * 64), params, LDS_BYTES, stream);
    if (e != hipSuccess) fprintf(stderr, "kernel_launch: cooperative launch failed: %s (grid %d)\n", hipGetErrorString(e), grid);
}
```
